# Optimizing an MI355X kernel written in HIP

```python
import jax, jax.numpy as jnp
from jax import lax
import numpy as np

D_MODEL = 1024
BATCH = 32
SEQ = 256
DEPTH = 1
DEC_BATCH = 2
DEC_SEQ = 1024
PAST_LEN = 256

GRID_W = 64
HEAD_DIM = 64
A_HEADS = 8
A_KV_HEADS = 2
A_WINDOW = 128
A_BLOCK = 128
B_HEADS = 8
NA_ROWS = 8
NA_COLS = 16
D_FF = -(-8 * D_MODEL // (3 * 256)) * 256
ROPE_BASE = 10000.0
RMS_EPS = 1e-6
NEG = -1e30

A_Q = A_HEADS * HEAD_DIM
A_KV = A_KV_HEADS * HEAD_DIM
B_W = B_HEADS * HEAD_DIM
D_IN = A_Q + 2 * A_KV + 3 * B_W + 2 * D_MODEL
SPLITS = [A_Q, A_Q + A_KV, A_Q + 2 * A_KV, A_Q + 2 * A_KV + B_W,
          A_Q + 2 * A_KV + 2 * B_W, A_Q + 2 * A_KV + 3 * B_W,
          A_Q + 2 * A_KV + 3 * B_W + D_MODEL]

kernel_name = "hybrid_dit_window_natten_prefix_step"


def rmsnorm(x, g):
    xf = x.astype(jnp.float32)
    y = xf * lax.rsqrt(jnp.mean(xf * xf, axis=-1, keepdims=True) + RMS_EPS)
    return (y * g.astype(jnp.float32)).astype(x.dtype)


def ada_mod(cvec, w_ada_l, b_ada_l):
    m = jax.nn.silu(cvec) @ w_ada_l + b_ada_l
    return jnp.split(m, 6, axis=-1)


def modulate(h, shift, scale):
    return h * (1 + scale) + shift


def rope_axis(x, pos):
    half = x.shape[-1] // 2
    inv_freq = 1.0 / (ROPE_BASE ** (jnp.arange(half, dtype=jnp.float32) / half))
    ang = pos.astype(jnp.float32)[:, None] * inv_freq[None, :]
    cos = jnp.cos(ang)[:, None, :]
    sin = jnp.sin(ang)[:, None, :]
    xf = x.astype(jnp.float32)
    x1, x2 = xf[..., :half], xf[..., half:]
    return jnp.concatenate([x1 * cos - x2 * sin, x2 * cos + x1 * sin], axis=-1).astype(x.dtype)


def rope_2d(x):
    n = x.shape[1]
    t = jnp.arange(n)
    d2 = HEAD_DIM // 2
    return jnp.concatenate([rope_axis(x[..., :d2], t // GRID_W), rope_axis(x[..., d2:], t % GRID_W)], axis=-1)


def project(h, w_in_l, qn_a, kn_a, qn_b, kn_b):
    u = h @ w_in_l
    qa, ka, va, qb, kb, vb, ga, gb = jnp.split(u, SPLITS, axis=-1)
    lead = h.shape[:-1]
    qa = rmsnorm(qa.reshape(*lead, A_HEADS, HEAD_DIM), qn_a)
    ka = rmsnorm(ka.reshape(*lead, A_KV_HEADS, HEAD_DIM), kn_a)
    va = va.reshape(*lead, A_KV_HEADS, HEAD_DIM)
    qb = rmsnorm(qb.reshape(*lead, B_HEADS, HEAD_DIM), qn_b)
    kb = rmsnorm(kb.reshape(*lead, B_HEADS, HEAD_DIM), kn_b)
    vb = vb.reshape(*lead, B_HEADS, HEAD_DIM)
    return qa, ka, va, qb, kb, vb, ga, gb


def merge_out(ya, yb, ga, gb, w_out_a_l, w_out_b_l, w_o_l):
    return (jax.nn.sigmoid(ga) * (ya @ w_out_a_l) + jax.nn.sigmoid(gb) * (yb @ w_out_b_l)) @ w_o_l


def swiglu(h, wg, wu, wd):
    return (jax.nn.silu(h @ wg) * (h @ wu)) @ wd


def ctx_attention(q, k, v, sink):
    b, l, h, d = q.shape
    kv = k.shape[2]
    g = h // kv
    m = k.shape[1]
    qg = q.reshape(b, l, kv, g, d)
    s = jnp.einsum('blkgd,bmkd->bkglm', qg, k).astype(jnp.float32) * (d ** -0.5)
    if sink is not None:
        s_sink = jnp.broadcast_to(sink.reshape(kv, g)[None, :, :, None, None].astype(jnp.float32), (b, kv, g, l, 1))
        s = jnp.concatenate([s, s_sink], axis=-1)
    p = jax.nn.softmax(s, axis=-1)[..., :m].astype(v.dtype)
    return jnp.einsum('bkglm,bmkd->blkgd', p, v).reshape(b, l, h * d)


def window_attention(q, k, v, ck, cv, sink):
    b, n, h, d = q.shape
    kv = k.shape[2]
    g = h // kv
    nb = n // A_BLOCK
    lc = ck.shape[1]
    qb = q.reshape(b, nb, A_BLOCK, kv, g, d)
    pad = ((0, 0), (A_BLOCK, A_BLOCK), (0, 0), (0, 0))
    kp = jnp.pad(k, pad).reshape(b, nb + 2, A_BLOCK, kv, d)
    vp = jnp.pad(v, pad).reshape(b, nb + 2, A_BLOCK, kv, d)
    kb = jnp.concatenate([kp[:, :nb], kp[:, 1:nb + 1], kp[:, 2:]], axis=2)
    vb = jnp.concatenate([vp[:, :nb], vp[:, 1:nb + 1], vp[:, 2:]], axis=2)
    qpos = jnp.arange(n).reshape(nb, A_BLOCK)
    kpos = (jnp.arange(nb)[:, None] - 1) * A_BLOCK + jnp.arange(3 * A_BLOCK)[None, :]
    kq = kpos[:, None, :]
    valid = (jnp.abs(qpos[:, :, None] - kq) <= A_WINDOW) & (kq >= 0) & (kq < n)
    scale = d ** -0.5
    s_loc = jnp.einsum('bnqkgd,bnskd->bnkgqs', qb, kb).astype(jnp.float32) * scale
    s_loc = jnp.where(valid[None, :, None, None], s_loc, NEG)
    s_ctx = jnp.einsum('bnqkgd,blkd->bnkgql', qb, ck).astype(jnp.float32) * scale
    s_sink = jnp.broadcast_to(sink.reshape(kv, g)[None, None, :, :, None, None].astype(jnp.float32), (b, nb, kv, g, A_BLOCK, 1))
    p = jax.nn.softmax(jnp.concatenate([s_loc, s_ctx, s_sink], axis=-1), axis=-1)
    p_loc = p[..., :3 * A_BLOCK].astype(v.dtype)
    p_ctx = p[..., 3 * A_BLOCK:3 * A_BLOCK + lc].astype(v.dtype)
    out = jnp.einsum('bnkgqs,bnskd->bnqkgd', p_loc, vb) + jnp.einsum('bnkgql,blkd->bnqkgd', p_ctx, cv)
    return out.reshape(b, n, h * d)


def neighbourhood_attention(q, k, v, ck, cv, rpb):
    b, n, h, d = q.shape
    rows_n = n // GRID_W
    wr = min(NA_ROWS, rows_n)
    s_len = wr * GRID_W
    rq = jnp.arange(rows_n)
    rs = jnp.clip(rq - wr // 2, 0, rows_n - wr)
    rows = rs[:, None] + jnp.arange(wr)[None, :]
    kg = k.reshape(b, rows_n, GRID_W, h, d)[:, rows].reshape(b, rows_n, s_len, h, d)
    vg = v.reshape(b, rows_n, GRID_W, h, d)[:, rows].reshape(b, rows_n, s_len, h, d)
    qg = q.reshape(b, rows_n, GRID_W, h, d)
    cq = jnp.arange(GRID_W)
    cs = jnp.clip(cq - NA_COLS // 2, 0, GRID_W - NA_COLS)
    kcol = jnp.arange(s_len) % GRID_W
    krow = jnp.repeat(rows, GRID_W, axis=1)
    col_valid = (kcol[None, :] >= cs[:, None]) & (kcol[None, :] < cs[:, None] + NA_COLS)
    dr = krow - rq[:, None] + (NA_ROWS - 1)
    dc = jnp.clip(kcol[None, :] - cq[:, None], -(NA_COLS - 1), NA_COLS - 1) + (NA_COLS - 1)
    bias = jnp.transpose(rpb[:, dr[:, None, :], dc[None, :, :]], (1, 0, 2, 3))
    scale = d ** -0.5
    s_loc = jnp.einsum('brqhd,brshd->brhqs', qg, kg).astype(jnp.float32) * scale + bias.astype(jnp.float32)[None]
    s_loc = jnp.where(col_valid[None, None, None], s_loc, NEG)
    s_ctx = jnp.einsum('brqhd,blhd->brhql', qg, ck).astype(jnp.float32) * scale
    p = jax.nn.softmax(jnp.concatenate([s_loc, s_ctx], axis=-1), axis=-1)
    p_loc = p[..., :s_len].astype(v.dtype)
    p_ctx = p[..., s_len:].astype(v.dtype)
    out = jnp.einsum('brhqs,brshd->brqhd', p_loc, vg) + jnp.einsum('brhql,blhd->brqhd', p_ctx, cv)
    return out.reshape(b, n, h * d)


def setup_inputs(seed: int = 0) -> dict:
    key = jax.random.key(seed)
    ks = jax.random.split(key, 26)
    f32 = jnp.float32
    nrm = lambda k, s: jax.random.normal(k, s, dtype=f32)
    return {
        "x_prompt": nrm(ks[0], (BATCH, SEQ, D_MODEL)),
        "x_sample": nrm(ks[1], (DEC_BATCH, DEC_SEQ, D_MODEL)),
        "cache_a_k": nrm(ks[2], (DEC_BATCH, DEPTH, PAST_LEN, A_KV_HEADS, HEAD_DIM)),
        "cache_a_v": nrm(ks[3], (DEC_BATCH, DEPTH, PAST_LEN, A_KV_HEADS, HEAD_DIM)),
        "cache_b_k": nrm(ks[4], (DEC_BATCH, DEPTH, PAST_LEN, B_HEADS, HEAD_DIM)),
        "cache_b_v": nrm(ks[5], (DEC_BATCH, DEPTH, PAST_LEN, B_HEADS, HEAD_DIM)),
        "c": nrm(ks[6], (DEC_BATCH, D_MODEL)),
        "c_ctx": nrm(ks[7], (D_MODEL,)),
        "w_ada": nrm(ks[8], (DEPTH, D_MODEL, 6 * D_MODEL)) * (0.5 * D_MODEL ** -0.5),
        "b_ada": nrm(ks[9], (DEPTH, 6 * D_MODEL)) * 0.02,
        "g_attn": 1.0 + 0.05 * nrm(ks[10], (DEPTH, D_MODEL)),
        "w_in": nrm(ks[11], (DEPTH, D_MODEL, D_IN)) * D_MODEL ** -0.5,
        "q_norm_a": 1.0 + 0.05 * nrm(ks[12], (DEPTH, HEAD_DIM)),
        "k_norm_a": 1.0 + 0.05 * nrm(ks[13], (DEPTH, HEAD_DIM)),
        "q_norm_b": 1.0 + 0.05 * nrm(ks[14], (DEPTH, HEAD_DIM)),
        "k_norm_b": 1.0 + 0.05 * nrm(ks[15], (DEPTH, HEAD_DIM)),
        "sink_a": nrm(ks[16], (DEPTH, A_HEADS)),
        "rpb_b": 0.1 * nrm(ks[17], (DEPTH, B_HEADS, 2 * NA_ROWS - 1, 2 * NA_COLS - 1)),
        "w_out_a": nrm(ks[18], (DEPTH, A_Q, D_MODEL)) * A_Q ** -0.5,
        "w_out_b": nrm(ks[19], (DEPTH, B_W, D_MODEL)) * B_W ** -0.5,
        "w_o": nrm(ks[20], (DEPTH, D_MODEL, D_MODEL)) * D_MODEL ** -0.5,
        "g_ffn": 1.0 + 0.05 * nrm(ks[21], (DEPTH, D_MODEL)),
        "w_gate": nrm(ks[22], (DEPTH, D_MODEL, D_FF)) * D_MODEL ** -0.5,
        "w_up": nrm(ks[23], (DEPTH, D_MODEL, D_FF)) * D_MODEL ** -0.5,
        "w_down": nrm(ks[24], (DEPTH, D_FF, D_MODEL)) * D_FF ** -0.5,
    }


def reference(x_prompt, x_sample, cache_a_k, cache_a_v, cache_b_k, cache_b_v, c, c_ctx,
              w_ada, b_ada, g_attn, w_in, q_norm_a, k_norm_a, q_norm_b, k_norm_b,
              sink_a, rpb_b, w_out_a, w_out_b, w_o, g_ffn, w_gate, w_up, w_down):
    xp = x_prompt
    xs = x_sample
    ak_list, av_list, bk_list, bv_list = [], [], [], []
    for l in range(DEPTH):
        sh1, sc1, gt1, sh2, sc2, gt2 = ada_mod(c_ctx, w_ada[l], b_ada[l])
        h = modulate(rmsnorm(xp, g_attn[l]), sh1, sc1)
        qa, ka, va, qb, kb, vb, ga, gb = project(h, w_in[l], q_norm_a[l], k_norm_a[l], q_norm_b[l], k_norm_b[l])
        ya = ctx_attention(qa, ka, va, sink_a[l])
        yb = ctx_attention(qb, kb, vb, None)
        xp = xp + gt1 * merge_out(ya, yb, ga, gb, w_out_a[l], w_out_b[l], w_o[l])
        xp = xp + gt2 * swiglu(modulate(rmsnorm(xp, g_ffn[l]), sh2, sc2), w_gate[l], w_up[l], w_down[l])
        ak_list.append(ka)
        av_list.append(va)
        bk_list.append(kb)
        bv_list.append(vb)

        sh1, sc1, gt1, sh2, sc2, gt2 = [m[:, None, :] for m in ada_mod(c, w_ada[l], b_ada[l])]
        h = modulate(rmsnorm(xs, g_attn[l]), sh1, sc1)
        qa, ka, va, qb, kb, vb, ga, gb = project(h, w_in[l], q_norm_a[l], k_norm_a[l], q_norm_b[l], k_norm_b[l])
        qa = rope_2d(qa)
        ka = rope_2d(ka)
        ya = window_attention(qa, ka, va, cache_a_k[:, l], cache_a_v[:, l], sink_a[l])
        yb = neighbourhood_attention(qb, kb, vb, cache_b_k[:, l], cache_b_v[:, l], rpb_b[l])
        xs = xs + gt1 * merge_out(ya, yb, ga, gb, w_out_a[l], w_out_b[l], w_o[l])
        xs = xs + gt2 * swiglu(modulate(rmsnorm(xs, g_ffn[l]), sh2, sc2), w_gate[l], w_up[l], w_down[l])
    new_a_k = jnp.stack(ak_list, axis=1)
    new_a_v = jnp.stack(av_list, axis=1)
    new_b_k = jnp.stack(bk_list, axis=1)
    new_b_v = jnp.stack(bv_list, axis=1)
    return (xp, xs, new_a_k, new_a_v, new_b_k, new_b_v)
```

```cpp
#include <hip/hip_runtime.h>
#include <hip/hip_cooperative_groups.h>
#include <cstdio>
#include <cstdint>
namespace cg = cooperative_groups;
namespace pg8 {
#define PG8_LAS __attribute__((address_space(3)))
typedef unsigned short bf16_t;
typedef short bf16x8 __attribute__((ext_vector_type(8)));
typedef float f32x4 __attribute__((ext_vector_type(4)));
typedef unsigned u32x4 __attribute__((ext_vector_type(4)));
constexpr int BM = 256, BK = 64, HALF = 128, HTB = HALF * BK * 2  , STAGE_BYTES = 8 * HTB, NXCD = 8, WGM = 8;

__host__ __device__ __forceinline__ int lds_byte(int r, int c) { const int st = (r >> 4) * 2 + (c >> 5), rr = r & 15, cc = c & 31, ob = rr * 64 + cc * 2; return st * 1024 + (ob ^ (((ob >> 9) & 1) << 5)); }
__host__ __device__ __forceinline__ void stage_rc(int b, int& R, int& C) { const int st = b / 1024, sb = b % 1024, swz = sb ^ (((sb >> 9) & 1) << 5); R = (st >> 1) * 16 + swz / 64; C = (st & 1) * 32 + (swz % 64) / 2; }
__host__ __device__ __forceinline__ int perm32(int rho) { const int n = rho >> 4, i = rho & 15; return 8 * (i >> 2) + 4 * n + (i & 3); }

struct Unit { int pm, pn; };
struct Gemm { const bf16_t* A; const bf16_t* Bt; int M, N, K; };

struct StaticOrder {
    int nM, nN, nwg, G, c;
    __host__ __device__ void init(int M, int N, int G_, int c_) { nM = M / BM; nN = N / BM; nwg = nM * nN; G = G_; c = c_; }
    __host__ __device__ bool next(int i, Unit& u) const {
        const long L = (long)i * G + c; if (L >= nwg) return false;
        int wgid = (int)L; { const int q = nwg / NXCD, r = nwg % NXCD, xcd = wgid % NXCD, off = wgid / NXCD; wgid = (xcd < r ? xcd * (q + 1) : r * (q + 1) + (xcd - r) * q) + off; }
        const int nig = WGM * nN, gid = wgid / nig, fm = gid * WGM, gsz = (nM - fm) < WGM ? (nM - fm) : WGM;
        u.pm = fm + ((wgid % nig) % gsz); u.pn = (wgid % nig) / gsz; return true;
    }
    __device__ __forceinline__ void a_ready(const Unit&) const {}
    __device__ __forceinline__ void done(const Unit&) const {}
};

__device__ __forceinline__ unsigned cvt_pk_bf16(float lo, float hi) { unsigned r; asm volatile("v_cvt_pk_bf16_f32 %0, %1, %2" : "=v"(r) : "v"(lo), "v"(hi)); return r; }

template <class Epi, class Sched, bool ALIGN_EPI = false, bool SP2 = false>
__device__ __forceinline__ void gemm_phase(PG8_LAS unsigned char* lds, const Gemm g, const Sched& S, const Epi& E) {
    const int tid = threadIdx.x, wid = __builtin_amdgcn_readfirstlane(tid >> 6), lane = tid & 63, wr = wid >> 2, wc = wid & 3, fr = lane & 15, fq = lane >> 4;
    const int K = g.K, nt = K / BK;
    unsigned voffA[2], voffB[2];
#pragma unroll
    for (int i = 0; i < 2; ++i) { int R, C; stage_rc(tid * 16 + i * 8192, R, C); const int Rb = Epi::PERM ? ((R & ~31) + perm32(R & 31)) : R;
        voffA[i] = (unsigned)(R * K + C) * 2u; voffB[i] = (unsigned)(Rb * K + C) * 2u; }
    const size_t kstep = (size_t)(BK * 2);
    const size_t hstep = (size_t)HALF * K * 2;
    const size_t tstep = 2 * hstep;
    const unsigned ldsw = (unsigned)wid * 1024u;
    const int aoff = lds_byte(wr * 64 + fr, fq * 8), boff = lds_byte(wc * 32 + fr, fq * 8);
#define PG8_SA(b, h) (((b) * 2 + (h)) * HTB)
#define PG8_SB(b, h) ((4 + (b) * 2 + (h)) * HTB)
#define PG8_STAGE(bufoff, gbase, voff) do { _Pragma("unroll") for (int _i = 0; _i < 2; ++_i) \
        __builtin_amdgcn_global_load_lds((const unsigned*)((const char*)(gbase) + (voff)[_i]), (PG8_LAS unsigned*)(lds + (bufoff) + ldsw + _i * 8192), 16, 0, 0); } while (0)
#define PG8_LDA(dst, b, h) do { _Pragma("unroll") for (int m = 0; m < 4; ++m) _Pragma("unroll") for (int k = 0; k < 2; ++k) dst[m][k] = *(const PG8_LAS bf16x8*)(lds + PG8_SA(b, h) + aoff + m * 2048 + k * 1024); } while (0)
#define PG8_LDB(dst, b, h) do { _Pragma("unroll") for (int n = 0; n < 2; ++n) _Pragma("unroll") for (int k = 0; k < 2; ++k) dst[n][k] = *(const PG8_LAS bf16x8*)(lds + PG8_SB(b, h) + boff + n * 2048 + k * 1024); } while (0)
#define PG8_MMA(ai, bj, At, Bt) do { __builtin_amdgcn_s_setprio(1); _Pragma("unroll") for (int m = 0; m < 4; ++m) _Pragma("unroll") for (int n = 0; n < 2; ++n) _Pragma("unroll") for (int k = 0; k < 2; ++k) \
        acc[ai][bj][m][n] = __builtin_amdgcn_mfma_f32_16x16x32_bf16(Bt[n][k], At[m][k], acc[ai][bj][m][n], 0, 0, 0); __builtin_amdgcn_s_setprio(0); } while (0)
#define PG8_WAIT_V(n) asm volatile("s_waitcnt vmcnt(" #n ")" ::: "memory")
#define PG8_WAIT_L(n) asm volatile("s_waitcnt lgkmcnt(" #n ")" ::: "memory")
#define PG8_BAR __builtin_amdgcn_s_barrier()
#define PG8_SCHED __builtin_amdgcn_sched_barrier(0)
    Unit cur, nxt; int ui = 0;
    if (!S.next(0, cur)) return;
    f32x4 acc[2][2][4][2];
#pragma unroll
    for (int a = 0; a < 2; ++a)
#pragma unroll
        for (int b = 0; b < 2; ++b)
#pragma unroll
            for (int m = 0; m < 4; ++m)
#pragma unroll
                for (int n = 0; n < 2; ++n) acc[a][b][m][n] = (f32x4){0.f, 0.f, 0.f, 0.f};
    bf16x8 At[4][2], B0[2][2], B1[2][2];
    const char* cA = (const char*)g.A + (size_t)cur.pm * tstep; const char* cB = (const char*)g.Bt + (size_t)cur.pn * tstep;
    S.a_ready(cur);
    if constexpr (SP2) {
        PG8_STAGE(PG8_SB(0, 0), cB, voffB); PG8_STAGE(PG8_SB(0, 1), cB + hstep, voffB); PG8_STAGE(PG8_SA(0, 0), cA, voffA); PG8_STAGE(PG8_SA(0, 1), cA + hstep, voffA);
        if (wr == 1) PG8_BAR;
        PG8_WAIT_V(2); PG8_BAR;
        PG8_STAGE(PG8_SB(1, 0), cB + kstep, voffB); PG8_STAGE(PG8_SA(1, 0), cA + kstep, voffA); PG8_STAGE(PG8_SB(1, 1), cB + hstep + kstep, voffB);
        PG8_WAIT_V(6); PG8_BAR;
    } else {
        PG8_STAGE(PG8_SB(0, 0), cB, voffB); PG8_STAGE(PG8_SA(0, 0), cA, voffA); PG8_STAGE(PG8_SB(0, 1), cB + hstep, voffB); PG8_STAGE(PG8_SA(0, 1), cA + hstep, voffA);
        if (wr == 1) PG8_BAR;
        PG8_WAIT_V(4); PG8_BAR;
        PG8_STAGE(PG8_SB(1, 0), cB + kstep, voffB); PG8_STAGE(PG8_SA(1, 0), cA + kstep, voffA); PG8_STAGE(PG8_SB(1, 1), cB + hstep + kstep, voffB);
        PG8_WAIT_V(6); PG8_BAR;
    }
    for (;;) {
        const bool has_next = S.next(ui + 1, nxt);
        const char* nA = has_next ? (const char*)g.A + (size_t)nxt.pm * tstep : cA; const char* nB = has_next ? (const char*)g.Bt + (size_t)nxt.pn * tstep : cB;
        for (int t = 0; t < nt; t += 2) {
            const bool last = (t == nt - 2);
            const char* a1 = cA + (size_t)(t + 1) * kstep;
            const char* a2 = last ? nA : cA + (size_t)(t + 2) * kstep; const char* b2 = last ? nB : cB + (size_t)(t + 2) * kstep;
            const char* a3 = a2 + kstep; const char* b3 = b2 + kstep;
            if (last && has_next) S.a_ready(nxt);
            if constexpr (SP2) {
            PG8_LDB(B0, 0, 0); PG8_LDB(B1, 0, 1); PG8_SCHED; PG8_LDA(At, 0, 0); PG8_STAGE(PG8_SA(1, 1), a1 + hstep, voffA);
            PG8_WAIT_V(8); PG8_WAIT_L(0); PG8_BAR; PG8_MMA(0, 0, At, B0); PG8_MMA(0, 1, At, B1); PG8_BAR; PG8_SCHED;
            PG8_LDA(At, 0, 1); PG8_STAGE(PG8_SB(0, 0), b2, voffB); PG8_STAGE(PG8_SB(0, 1), b2 + hstep, voffB); PG8_STAGE(PG8_SA(0, 0), a2, voffA);
            PG8_WAIT_V(8); PG8_WAIT_L(0); PG8_BAR; PG8_MMA(1, 0, At, B0); PG8_MMA(1, 1, At, B1); PG8_BAR; PG8_SCHED;
            PG8_LDB(B0, 1, 0); PG8_LDB(B1, 1, 1); PG8_SCHED; PG8_LDA(At, 1, 0); PG8_STAGE(PG8_SA(0, 1), a2 + hstep, voffA);
            PG8_WAIT_V(8); PG8_WAIT_L(0); PG8_BAR; PG8_MMA(0, 0, At, B0); PG8_MMA(0, 1, At, B1); PG8_BAR; PG8_SCHED;
            PG8_LDA(At, 1, 1); PG8_STAGE(PG8_SB(1, 0), b3, voffB); PG8_STAGE(PG8_SB(1, 1), b3 + hstep, voffB); PG8_STAGE(PG8_SA(1, 0), a3, voffA);
            PG8_WAIT_V(8); PG8_WAIT_L(0); PG8_BAR; PG8_MMA(1, 0, At, B0); PG8_MMA(1, 1, At, B1); PG8_BAR; PG8_SCHED;
            } else {
            PG8_LDB(B0, 0, 0); PG8_SCHED; PG8_LDA(At, 0, 0); PG8_STAGE(PG8_SA(1, 1), a1 + hstep, voffA);
            PG8_WAIT_L(8); PG8_BAR; PG8_WAIT_L(0); PG8_MMA(0, 0, At, B0); PG8_BAR; PG8_SCHED;
            PG8_LDB(B1, 0, 1); PG8_STAGE(PG8_SB(0, 0), b2, voffB);
            PG8_BAR; PG8_WAIT_L(0); PG8_MMA(0, 1, At, B1); PG8_BAR;
            PG8_LDA(At, 0, 1); PG8_STAGE(PG8_SA(0, 0), a2, voffA);
            PG8_BAR; PG8_WAIT_L(0); PG8_MMA(1, 0, At, B0); PG8_BAR; PG8_SCHED;
            PG8_STAGE(PG8_SB(0, 1), b2 + hstep, voffB);
            PG8_WAIT_V(6); PG8_BAR; PG8_MMA(1, 1, At, B1); PG8_BAR;
            PG8_LDB(B0, 1, 0); PG8_SCHED; PG8_LDA(At, 1, 0); PG8_STAGE(PG8_SA(0, 1), a2 + hstep, voffA);
            PG8_WAIT_L(8); PG8_BAR; PG8_WAIT_L(0); PG8_MMA(0, 0, At, B0); PG8_BAR; PG8_SCHED;
            PG8_LDB(B1, 1, 1); PG8_STAGE(PG8_SB(1, 0), b3, voffB);
            PG8_BAR; PG8_WAIT_L(0); PG8_MMA(0, 1, At, B1); PG8_BAR;
            PG8_LDA(At, 1, 1); PG8_STAGE(PG8_SA(1, 0), a3, voffA);
            PG8_BAR; PG8_WAIT_L(0); PG8_MMA(1, 0, At, B0); PG8_BAR; PG8_SCHED;
            PG8_STAGE(PG8_SB(1, 1), b3 + hstep, voffB);
            PG8_WAIT_V(6); PG8_BAR; PG8_MMA(1, 1, At, B1); PG8_BAR;
            }
        }
        if constexpr (ALIGN_EPI) { if (wr == 0) PG8_BAR; }
        if constexpr (!Epi::AFTER_DRAIN) { E(acc, cur, wr, wc, fr, fq); S.done(cur); }
        if (!has_next) break;
#pragma unroll
        for (int a = 0; a < 2; ++a)
#pragma unroll
            for (int b = 0; b < 2; ++b)
#pragma unroll
                for (int m = 0; m < 4; ++m)
#pragma unroll
                    for (int n = 0; n < 2; ++n) acc[a][b][m][n] = (f32x4){0.f, 0.f, 0.f, 0.f};
        cur = nxt; cA = nA; cB = nB; ++ui;
        if constexpr (ALIGN_EPI) { if (wr == 1) PG8_BAR; }
    }
    PG8_WAIT_V(0);
    if constexpr (!ALIGN_EPI) { if (wr == 0) PG8_BAR; }
    PG8_BAR;
    if constexpr (Epi::AFTER_DRAIN) { E.fused(acc, cur, wr, wc, fr, fq, lds, wid, lane); S.done(cur); }
#undef PG8_SA
#undef PG8_SB
#undef PG8_STAGE
#undef PG8_LDA
#undef PG8_LDB
#undef PG8_MMA
#undef PG8_WAIT_V
#undef PG8_WAIT_L
#undef PG8_BAR
#undef PG8_SCHED
}
}

#define DI __device__ __forceinline__
#define LAS __attribute__((address_space(3)))
typedef unsigned short u16;
typedef float f32x4 __attribute__((ext_vector_type(4)));
typedef float f32x16 __attribute__((ext_vector_type(16)));
typedef float f32x2 __attribute__((ext_vector_type(2)));
typedef short bf16x8 __attribute__((ext_vector_type(8)));
typedef short s16x4 __attribute__((ext_vector_type(4)));
typedef unsigned u32x2 __attribute__((ext_vector_type(2)));
typedef unsigned u32x4 __attribute__((ext_vector_type(4)));
typedef __bf16 bf16x2_t __attribute__((ext_vector_type(2)));

constexpr int DM = 1024, NCTX = 8192, NLAT = 2048, MTOK = 10240, DIN = 4352, DFF = 2816, NGU = 2 * DFF;
constexpr int QKV_P = 2304, G_P = 2048;
constexpr size_t MiB = 1u << 20;
constexpr size_t WS_CTL = 0, CTL_BYTES = 128 * 1024, CTL_QUEUE = 81920;
constexpr size_t WS_ROPE = 512 * 1024;
constexpr size_t WS_WIN = 1 * MiB, WS_WOA = 10 * MiB, WS_WOB = 11 * MiB, WS_WO = 12 * MiB, WS_WGU = 14 * MiB, WS_WD = 25 * MiB;
constexpr size_t WS_CKA = 31 * MiB, WS_CKB = 31 * MiB + 128 * 1024, WS_VCA = 32 * MiB, WS_VCB = 32 * MiB + 128 * 1024;
constexpr size_t WS_VTA_CTX = 33 * MiB, WS_VTB_CTX = 35 * MiB, WS_VTA_LAT = 43 * MiB, WS_VTB_LAT = 44 * MiB;
constexpr size_t WS_H = 46 * MiB, WS_QKV = 66 * MiB, WS_G = 111 * MiB, WS_YA = 151 * MiB, WS_YB = 161 * MiB, WS_TMP = 171 * MiB, WS_T = 211 * MiB, WS_GU = 66 * MiB;
constexpr size_t OUT_Y = 0, OUT_AK = 10485760, OUT_AV = 11534336, OUT_BK = 12582912, OUT_BV = 16777216;
constexpr int LDS_BYTES = 147456;
constexpr float RMS_EPS = 1e-6f;

DI unsigned pk2(float lo, float hi) { f32x2 v = {lo, hi}; bf16x2_t b = __builtin_convertvector(v, bf16x2_t); return __builtin_bit_cast(unsigned, b); }
DI u16 bf1(float x) { return (u16)(pk2(x, 0.f) & 0xffffu); }
DI float wave_sum(float v) {
#pragma unroll
    for (int o = 1; o < 64; o <<= 1) v += __shfl_xor(v, o);
    return v;
}
DI float sigmoidf_(float x) { return 1.0f / (1.0f + __expf(-x)); }
DI float siluf_(float x) { return x / (1.0f + __expf(-x)); }

struct Args { const float* in[25]; float* out; unsigned char* ws; int ph_lo, ph_hi; };
enum { I_XP = 0, I_XS, I_CAK, I_CAV, I_CBK, I_CBV, I_C, I_CCTX, I_WADA, I_BADA, I_GATTN, I_WIN, I_QNA, I_KNA, I_QNB, I_KNB, I_SINK, I_RPB, I_WOA, I_WOB, I_WO, I_GFFN, I_WG, I_WU, I_WD };

DI int dest_row(int mode, int n) {
    if (mode == 0) return n;
    if (mode == 1) { const int pn = n >> 8, wc = (n >> 6) & 3, bj = (n >> 5) & 1, e = n & 31; return (pn << 8) + (bj << 7) + (wc << 5) + e; }
    const int pn = n >> 7, rem = n & 127, bj = rem >> 6, wc = (rem >> 4) & 3, e = rem & 15;
    return (pn << 8) + (bj << 7) + (wc << 5) + ((mode == 3) ? 16 : 0) + e;
}
DI void p0_transpose_item(const float* W, int K, int N, u16* WT, int mode, LAS float* scr, int item, int lane) {
    const int nblk = N / 32, kb = item / nblk, nb = item % nblk, k0 = 64 * kb, n0 = 32 * nb;
#pragma unroll 8
    for (int i = 0; i < 32; ++i) { const int kk = 2 * i + (lane >> 5); scr[kk * 33 + (lane & 31)] = W[(size_t)(k0 + kk) * N + n0 + (lane & 31)]; }
    asm volatile("s_waitcnt lgkmcnt(0)" ::: "memory");
    const int c = lane & 7;
#pragma unroll
    for (int j = 0; j < 4; ++j) { const int n = (lane >> 3) + 8 * j; const LAS float* s = scr + (8 * c) * 33 + n;
        u32x4 o; o.x = pk2(s[0 * 33], s[1 * 33]); o.y = pk2(s[2 * 33], s[3 * 33]); o.z = pk2(s[4 * 33], s[5 * 33]); o.w = pk2(s[6 * 33], s[7 * 33]);
        *(u32x4*)(WT + (size_t)dest_row(mode, n0 + n) * K + k0 + 8 * c) = o; }
    asm volatile("s_waitcnt lgkmcnt(0)" ::: "memory");
}

DI void p0_prologue(const Args& a, LAS unsigned char* lds) {
    const int tid = threadIdx.x, lane = tid & 63, wave = __builtin_amdgcn_readfirstlane(tid >> 6);
    const int gw = blockIdx.x * 8 + wave, NGW = gridDim.x * 8;
    unsigned char* ws = a.ws;
    LAS float* scr = (LAS float*)(lds + wave * 16384);
    float* ada = (float*)(ws + WS_CTL);
    for (int it = gw; it < 24 * 32; it += NGW) {
        const int cgp = it % 24, kc = it / 24, col = cgp * 256 + 4 * lane;
        const float* wp = a.in[I_WADA] + (size_t)(kc * 32) * 6144 + col;
        f32x4 acc0 = {0, 0, 0, 0}, acc1 = acc0, acc2 = acc0;
#pragma unroll 8
        for (int k = 0; k < 32; ++k) {
            const f32x4 w = *(const f32x4*)(wp + (size_t)k * 6144);
            const int kk = kc * 32 + k;
            const float s0 = siluf_(a.in[I_CCTX][kk]), s1 = siluf_(a.in[I_C][kk]), s2 = siluf_(a.in[I_C][1024 + kk]);
            acc0 += w * s0; acc1 += w * s1; acc2 += w * s2;
        }
        if (kc == 0) { const f32x4 b = *(const f32x4*)(a.in[I_BADA] + col); acc0 += b; acc1 += b; acc2 += b; }
#pragma unroll
        for (int j = 0; j < 4; ++j) { atomicAdd(ada + col + j, acc0[j]); atomicAdd(ada + 6144 + col + j, acc1[j]); atomicAdd(ada + 12288 + col + j, acc2[j]); }
    }
    constexpr int I_IN = 16 * (DIN / 32), I_OA = 8 * 32, I_OB = 8 * 32, I_O = 16 * 32, I_G = 16 * (DFF / 32), I_U = I_G, I_D = (DFF / 64) * 32;
    constexpr int NITEMS = I_IN + I_OA + I_OB + I_O + I_G + I_U + I_D;
    for (int it = gw; it < NITEMS; it += NGW) {
        int r = it;
        if (r < I_IN) { p0_transpose_item(a.in[I_WIN], DM, DIN, (u16*)(ws + WS_WIN), 1, scr, r, lane); continue; } r -= I_IN;
        if (r < I_OA) { p0_transpose_item(a.in[I_WOA], 512, DM, (u16*)(ws + WS_WOA), 0, scr, r, lane); continue; } r -= I_OA;
        if (r < I_OB) { p0_transpose_item(a.in[I_WOB], 512, DM, (u16*)(ws + WS_WOB), 0, scr, r, lane); continue; } r -= I_OB;
        if (r < I_O) { p0_transpose_item(a.in[I_WO], DM, DM, (u16*)(ws + WS_WO), 0, scr, r, lane); continue; } r -= I_O;
        if (r < I_G) { p0_transpose_item(a.in[I_WG], DM, DFF, (u16*)(ws + WS_WGU), 2, scr, r, lane); continue; } r -= I_G;
        if (r < I_U) { p0_transpose_item(a.in[I_WU], DM, DFF, (u16*)(ws + WS_WGU), 3, scr, r, lane); continue; } r -= I_U;
        p0_transpose_item(a.in[I_WD], DFF, DM, (u16*)(ws + WS_WD), 0, scr, r, lane);
    }
    if (blockIdx.x == 0) { for (int i = tid; i < 64 * 16; i += 512) { const int pos = i >> 4, fi = i & 15; const float ang = (float)pos * exp2f(-(float)fi * (13.287712379549449f / 16.0f));
        float* rt = (float*)(ws + WS_ROPE) + (pos * 4 + (fi >> 2)) * 8 + (fi & 3); rt[0] = cosf(ang); rt[4] = sinf(ang); } }
    const int gt = blockIdx.x * 512 + tid, NGT = gridDim.x * 512;
    for (int i = gt; i < 2 * 256 * 128; i += NGT) {
        ((u16*)(ws + WS_CKA))[i] = bf1(a.in[I_CAK][i]);
        const int d = i & 63, hd = (i >> 6) & 1, key = (i >> 7) & 255, b = i >> 15;
        ((u16*)(ws + WS_VCA))[((b * 2 + hd) * 64 + d) * 256 + key] = bf1(a.in[I_CAV][i]);
    }
    for (int i = gt; i < 2 * 256 * 512; i += NGT) {
        ((u16*)(ws + WS_CKB))[i] = bf1(a.in[I_CBK][i]);
        const int d = i & 63, hd = (i >> 6) & 7, key = (i >> 9) & 255, b = i >> 17;
        ((u16*)(ws + WS_VCB))[((b * 8 + hd) * 64 + d) * 256 + key] = bf1(a.in[I_CBV][i]);
    }
}

DI void norm_mod_phase(const Args& a, int which) {
    const int tid = threadIdx.x, lane = tid & 63, wave = tid >> 6;
    const int gw = blockIdx.x * 8 + wave, NGW = gridDim.x * 8;
    const float* ada = (const float*)(a.ws + WS_CTL);
    const float* g = a.in[which ? I_GFFN : I_GATTN];
    u16* H = (u16*)(a.ws + WS_H);
    for (int r = gw; r < MTOK; r += NGW) {
        const float* xrow = which ? (a.out + OUT_Y + (size_t)r * DM) : (r < NCTX ? a.in[I_XP] + (size_t)r * DM : a.in[I_XS] + (size_t)(r - NCTX) * DM);
        const int grp = r < NCTX ? 0 : 1 + ((r - NCTX) >> 10);
        const float* sh = ada + grp * 6144 + (which ? 3072 : 0);
        const float* sc = sh + 1024;
        f32x4 v[4]; float ss = 0.f;
#pragma unroll
        for (int j = 0; j < 4; ++j) { v[j] = *(const f32x4*)(xrow + 4 * lane + 256 * j); ss += (v[j].x * v[j].x + v[j].y * v[j].y) + (v[j].z * v[j].z + v[j].w * v[j].w); }
        const float rstd = rsqrtf(wave_sum(ss) * (1.f / DM) + RMS_EPS);
#pragma unroll
        for (int j = 0; j < 4; ++j) {
            const int c = 4 * lane + 256 * j;
            const f32x4 gg = *(const f32x4*)(g + c), s1 = *(const f32x4*)(sc + c), s0 = *(const f32x4*)(sh + c);
            const f32x4 y = (v[j] * rstd * gg) * (s1 + 1.0f) + s0;
            u32x2 o; o.x = pk2(y.x, y.y); o.y = pk2(y.z, y.w);
            *(u32x2*)(H + (size_t)r * DM + c) = o;
        }
    }
}
typedef const pg8::f32x4 (&AccRef)[2][2][4][2];

struct EpiIn {
    static constexpr bool PERM = false, AFTER_DRAIN = false;
    const Args* a;
    DI void operator()(AccRef acc, const pg8::Unit& u, int wr, int wc, int fr, int fq) const {
        asm volatile("" : "+v"(fr), "+v"(fq));
        unsigned char* ws = a->ws;
        const int pn = u.pn, pm = u.pm;
        const bool lat = pm >= 32;
        const int row0 = pm * 256 + wr * 64 + fr;
        if (pn >= 9) {
            u16* G = (u16*)(ws + WS_G);
#pragma unroll
            for (int ai = 0; ai < 2; ++ai)
#pragma unroll
                for (int m = 0; m < 4; ++m) { u16* rp = G + (size_t)(row0 + ai * 128 + m * 16) * G_P + (pn - 9) * 256 + wc * 64 + 4 * fq;
#pragma unroll
                    for (int bj = 0; bj < 2; ++bj)
#pragma unroll
                        for (int n = 0; n < 2; ++n) { const pg8::f32x4 v = acc[ai][bj][m][n]; u32x2 o; o.x = pk2(sigmoidf_(v[0]), sigmoidf_(v[1])); o.y = pk2(sigmoidf_(v[2]), sigmoidf_(v[3]));
                            *(u32x2*)(rp + 32 * bj + 16 * n) = o; } }
            return;
        }
        const bool isv = (pn == 2 && wc >= 2) || pn == 7 || pn == 8;
        if (isv) {
            int nh, hd; u16* vt; float* ov;
            if (pn == 2) { nh = 2; hd = wc - 2; vt = (u16*)(ws + (lat ? WS_VTA_LAT : WS_VTA_CTX)); ov = a->out + OUT_AV; }
            else { nh = 8; hd = (pn - 7) * 4 + wc; vt = (u16*)(ws + (lat ? WS_VTB_LAT : WS_VTB_CTX)); ov = a->out + OUT_BV; }
            const int Tsh = lat ? 10 : 8;
            const int bb = lat ? (pm - 32) >> 2 : pm;
            const unsigned t0 = (unsigned)((lat ? ((pm - 32) & 3) * 256 : 0) + wr * 64 + fr);
            u16* vb = vt + (((size_t)(bb * nh + hd) * 64) << Tsh);
#pragma unroll
            for (int ai = 0; ai < 2; ++ai)
#pragma unroll
                for (int m = 0; m < 4; ++m) {
#pragma unroll
                    for (int bj = 0; bj < 2; ++bj)
#pragma unroll
                        for (int n = 0; n < 2; ++n) { const pg8::f32x4 v = acc[ai][bj][m][n]; const unsigned d = 32 * bj + 16 * n + 4 * fq;
#pragma unroll
                            for (int j = 0; j < 4; ++j) vb[((d + j) << Tsh) + t0 + ai * 128 + m * 16] = bf1(v[j]);
                            if (!lat) *(pg8::f32x4*)(ov + (unsigned)(((row0 + ai * 128 + m * 16) * nh + hd) * 64) + d) = v; }
                    __builtin_amdgcn_sched_barrier(0); }
            return;
        }
        const float* nw; float* ok = nullptr; int nh = 0, hd = 0; bool rope = false;
        if (pn < 2) { nw = a->in[I_QNA]; rope = lat; }
        else if (pn == 2) { nw = a->in[I_KNA]; rope = lat; ok = a->out + OUT_AK; nh = 2; hd = wc; }
        else if (pn < 5) { nw = a->in[I_QNB]; }
        else { nw = a->in[I_KNB]; ok = a->out + OUT_BK; nh = 8; hd = (pn - 5) * 4 + wc; }
        u16* Q = (u16*)(ws + WS_QKV);
        pg8::f32x4 wv[2][2];
#pragma unroll
        for (int bj = 0; bj < 2; ++bj)
#pragma unroll
            for (int n = 0; n < 2; ++n) wv[bj][n] = *(const pg8::f32x4*)(nw + 32 * bj + 16 * n + 4 * fq);
        const float* rtab = (const float*)(ws + WS_ROPE) + fq * 8;
#pragma unroll
        for (int ai = 0; ai < 2; ++ai)
#pragma unroll
            for (int m = 0; m < 4; ++m) {
                const int r = row0 + ai * 128 + m * 16;
                pg8::f32x4 v[2][2]; float ss = 0.f;
#pragma unroll
                for (int bj = 0; bj < 2; ++bj)
#pragma unroll
                    for (int n = 0; n < 2; ++n) { v[bj][n] = acc[ai][bj][m][n]; ss += (v[bj][n][0] * v[bj][n][0] + v[bj][n][1] * v[bj][n][1]) + (v[bj][n][2] * v[bj][n][2] + v[bj][n][3] * v[bj][n][3]); }
                ss += __shfl_xor(ss, 16); ss += __shfl_xor(ss, 32);
                const float rs = rsqrtf(ss * (1.f / 64.f) + RMS_EPS);
#pragma unroll
                for (int bj = 0; bj < 2; ++bj)
#pragma unroll
                    for (int n = 0; n < 2; ++n) v[bj][n] = v[bj][n] * rs * wv[bj][n];
                if (rope) {
                    const int t = (r - NCTX) & 1023;
#pragma unroll
                    for (int bj = 0; bj < 2; ++bj) { const int pos = (bj == 0 ? (t >> 6) : (t & 63));
                        const pg8::f32x4 cs = *(const pg8::f32x4*)(rtab + pos * 32), sn = *(const pg8::f32x4*)(rtab + pos * 32 + 4);
                        const pg8::f32x4 x1 = v[bj][0], x2 = v[bj][1]; v[bj][0] = x1 * cs - x2 * sn; v[bj][1] = x2 * cs + x1 * sn; }
                }
                u16* rp = Q + (size_t)r * QKV_P + pn * 256 + wc * 64 + 4 * fq;
#pragma unroll
                for (int bj = 0; bj < 2; ++bj)
#pragma unroll
                    for (int n = 0; n < 2; ++n) { u32x2 o; o.x = pk2(v[bj][n][0], v[bj][n][1]); o.y = pk2(v[bj][n][2], v[bj][n][3]); *(u32x2*)(rp + 32 * bj + 16 * n) = o;
                        if (ok && !lat) *(pg8::f32x4*)(ok + ((size_t)r * nh + hd) * 64 + 32 * bj + 16 * n + 4 * fq) = v[bj][n]; }
                __builtin_amdgcn_sched_barrier(0);
            }
    }
};

template <int SECOND> struct EpiGate {
    static constexpr bool PERM = false, AFTER_DRAIN = false;
    const Args* a;
    DI void operator()(AccRef acc, const pg8::Unit& u, int wr, int wc, int fr, int fq) const {
        asm volatile("" : "+v"(fr), "+v"(fq));
        unsigned char* ws = a->ws;
        const u16* G = (const u16*)(ws + WS_G) + (SECOND ? 1024 : 0);
        float* TMP = (float*)(ws + WS_TMP); u16* T = (u16*)(ws + WS_T);
        const int row0 = u.pm * 256 + wr * 64 + fr, col0 = u.pn * 256 + wc * 32 + 4 * fq;
#pragma unroll
        for (int ai = 0; ai < 2; ++ai)
#pragma unroll
            for (int m = 0; m < 4; ++m) { const size_t r = row0 + ai * 128 + m * 16;
#pragma unroll
                for (int bj = 0; bj < 2; ++bj)
#pragma unroll
                    for (int n = 0; n < 2; ++n) { const int c = col0 + 128 * bj + 16 * n;
                        const u32x2 gb = *(const u32x2*)(G + r * G_P + c);
                        pg8::f32x4 gv; gv[0] = __uint_as_float(gb.x << 16); gv[1] = __uint_as_float(gb.x & 0xffff0000u); gv[2] = __uint_as_float(gb.y << 16); gv[3] = __uint_as_float(gb.y & 0xffff0000u);
                        pg8::f32x4 v = acc[ai][bj][m][n] * gv;
                        if (!SECOND) *(pg8::f32x4*)(TMP + r * DM + c) = v;
                        else { v += *(const pg8::f32x4*)(TMP + r * DM + c); u32x2 o; o.x = pk2(v[0], v[1]); o.y = pk2(v[2], v[3]); *(u32x2*)(T + r * DM + c) = o; } } }
    }
};

template <int FINAL> struct EpiRes {
    static constexpr bool PERM = false, AFTER_DRAIN = false;
    const Args* a;
    DI void operator()(AccRef acc, const pg8::Unit& u, int wr, int wc, int fr, int fq) const {
        asm volatile("" : "+v"(fr), "+v"(fq));
        const int pm = u.pm; const int grp = pm < 32 ? 0 : 1 + ((pm - 32) >> 2);
        const float* gate = (const float*)(a->ws + WS_CTL) + grp * 6144 + (FINAL ? 5120 : 2048);
        float* out = a->out + OUT_Y;
        const float* base = FINAL ? out : (pm < 32 ? a->in[I_XP] : a->in[I_XS] - (size_t)NCTX * DM);
        const int row0 = pm * 256 + wr * 64 + fr, col0 = u.pn * 256 + wc * 32 + 4 * fq;
        pg8::f32x4 gv[2][2];
#pragma unroll
        for (int bj = 0; bj < 2; ++bj)
#pragma unroll
            for (int n = 0; n < 2; ++n) gv[bj][n] = *(const pg8::f32x4*)(gate + col0 + 128 * bj + 16 * n);
#pragma unroll
        for (int ai = 0; ai < 2; ++ai)
#pragma unroll
            for (int m = 0; m < 4; ++m) { const size_t r = row0 + ai * 128 + m * 16;
#pragma unroll
                for (int bj = 0; bj < 2; ++bj)
#pragma unroll
                    for (int n = 0; n < 2; ++n) { const int c = col0 + 128 * bj + 16 * n;
                        const pg8::f32x4 b = *(const pg8::f32x4*)(base + r * DM + c);
                        *(pg8::f32x4*)(out + r * DM + c) = b + gv[bj][n] * acc[ai][bj][m][n]; } }
    }
};

struct EpiSwiglu {
    static constexpr bool PERM = false, AFTER_DRAIN = false;
    const Args* a;
    DI void operator()(AccRef acc, const pg8::Unit& u, int wr, int wc, int fr, int fq) const {
        asm volatile("" : "+v"(fr), "+v"(fq));
        u16* GU = (u16*)(a->ws + WS_GU);
        const int row0 = u.pm * 256 + wr * 64 + fr, col0 = u.pn * 128 + wc * 16 + 4 * fq;
#pragma unroll
        for (int ai = 0; ai < 2; ++ai)
#pragma unroll
            for (int m = 0; m < 4; ++m) { const size_t r = row0 + ai * 128 + m * 16;
#pragma unroll
                for (int bj = 0; bj < 2; ++bj) { const pg8::f32x4 g = acc[ai][bj][m][0], up = acc[ai][bj][m][1];
                    u32x2 o; o.x = pk2(siluf_(g[0]) * up[0], siluf_(g[1]) * up[1]); o.y = pk2(siluf_(g[2]) * up[2], siluf_(g[3]) * up[3]);
                    *(u32x2*)(GU + r * DFF + col0 + 64 * bj) = o; } }
    }
};
#define MFMA32(a, b, c) __builtin_amdgcn_mfma_f32_32x32x16_bf16((a), (b), (c), 0, 0, 0)
struct AState { float m, l; f32x16 o0, o1; };
struct AMask { int dq; int e0; const float* bp; };
DI int crow_(int i, int h) { return (i & 3) + 8 * (i >> 2) + 4 * h; }

template <int MODE>
DI void attn_tile(AState& st, const bf16x8 (&qf)[4], const u16* kp, const u16* vp, size_t v32, int h, const AMask& mk) {
    f32x16 s;
#pragma unroll
    for (int i = 0; i < 16; ++i) s[i] = 0.f;
    bf16x8 kf[4];
#pragma unroll
    for (int t = 0; t < 4; ++t) kf[t] = *(const bf16x8*)(kp + 16 * t);
    s16x4 va[2][2][2];
#pragma unroll
    for (int dt = 0; dt < 2; ++dt)
#pragma unroll
        for (int sI = 0; sI < 2; ++sI) { va[dt][sI][0] = *(const s16x4*)(vp + dt * v32 + 16 * sI); va[dt][sI][1] = *(const s16x4*)(vp + dt * v32 + 16 * sI + 8); }
#pragma unroll
    for (int t = 0; t < 4; ++t) s = MFMA32(kf[t], qf[t], s);
    float tmax = -1e30f;
#pragma unroll
    for (int i = 0; i < 16; ++i) {
        float v = s[i] * 0.125f; const int c = crow_(i, h);
        if (MODE == 1) { const int d = mk.dq - c; v = (d <= 128 && d >= -128) ? v : -INFINITY; }
        if (MODE == 2) { const bool ok = (unsigned)(mk.e0 + c) < 16u; const float b = ok ? mk.bp[c] : 0.f; v = ok ? v + b : -INFINITY; }
        s[i] = v; tmax = fmaxf(tmax, v);
    }
    tmax = fmaxf(tmax, __shfl_xor(tmax, 32));
    const float mnew = fmaxf(st.m, tmax), alpha = __expf(st.m - mnew);
    st.m = mnew;
    float psum = 0.f;
#pragma unroll
    for (int i = 0; i < 16; ++i) { const float p = __expf(s[i] - mnew); s[i] = p; psum += p; }
    st.l = st.l * alpha + psum;
#pragma unroll
    for (int i = 0; i < 16; ++i) { st.o0[i] *= alpha; st.o1[i] *= alpha; }
#pragma unroll
    for (int sI = 0; sI < 2; ++sI) {
        u32x4 pw; pw.x = pk2(s[8 * sI], s[8 * sI + 1]); pw.y = pk2(s[8 * sI + 2], s[8 * sI + 3]); pw.z = pk2(s[8 * sI + 4], s[8 * sI + 5]); pw.w = pk2(s[8 * sI + 6], s[8 * sI + 7]);
        const bf16x8 pb = __builtin_bit_cast(bf16x8, pw);
        const bf16x8 a0 = __builtin_shufflevector(va[0][sI][0], va[0][sI][1], 0, 1, 2, 3, 4, 5, 6, 7);
        const bf16x8 a1 = __builtin_shufflevector(va[1][sI][0], va[1][sI][1], 0, 1, 2, 3, 4, 5, 6, 7);
        st.o0 = MFMA32(a0, pb, st.o0);
        st.o1 = MFMA32(a1, pb, st.o1);
    }
}

constexpr int N_ITEMS_LB = 512, N_ITEMS_LA = 512, N_ITEMS_CTX = 4096, N_ITEMS = N_ITEMS_LB + N_ITEMS_LA + N_ITEMS_CTX;

DI void attn_phase(const Args& a) {
    const int lane = threadIdx.x & 63, r = lane & 31, h = lane >> 5;
    unsigned char* ws = a.ws;
    unsigned* queue = (unsigned*)(ws + WS_CTL + CTL_QUEUE);
    const u16* QKV = (const u16*)(ws + WS_QKV);
    for (;;) {
        unsigned it0 = 0;
        if (lane == 0) it0 = atomicAdd(queue, 1u);
        const int it = __builtin_amdgcn_readfirstlane(it0);
        if (it >= N_ITEMS) break;
        AState st;
#pragma unroll
        for (int i = 0; i < 16; ++i) { st.o0[i] = 0.f; st.o1[i] = 0.f; }
        st.m = -1e30f; st.l = 0.f;
        bf16x8 qf[4];
        u16* outp;
        AMask mk; mk.dq = 0; mk.e0 = 0; mk.bp = nullptr;
        if (it < N_ITEMS_LB) {
            const int b = it >> 8, hd = (it >> 5) & 7, qt = it & 31, rq = qt >> 1, c0q = (qt & 1) * 32;
            const size_t tok0 = (size_t)NCTX + b * 1024;
            const u16* qp = QKV + (tok0 + rq * 64 + c0q + r) * QKV_P + 768 + 64 * hd + 8 * h;
#pragma unroll
            for (int t = 0; t < 4; ++t) qf[t] = *(const bf16x8*)(qp + 16 * t);
            const int cq = c0q + r, cs = min(max(cq - 8, 0), 48), rs = min(max(rq - 4, 0), 8);
            const u16* vtb = (const u16*)(ws + WS_VTB_LAT) + ((size_t)(b * 8 + hd) * 64 + r) * 1024 + 4 * h;
            for (int kr = rs; kr < rs + 8; ++kr)
                for (int ct = 0; ct < 2; ++ct) {
                    const int key0 = kr * 64 + ct * 32, kc0 = ct * 32;
                    mk.e0 = kc0 - cs; mk.bp = a.in[I_RPB] + (hd * 15 + (kr - rq + 7)) * 31 + (kc0 - cq + 15);
                    attn_tile<2>(st, qf, QKV + (tok0 + key0 + r) * QKV_P + 1280 + 64 * hd + 8 * h, vtb + key0, (size_t)32 * 1024, h, mk);
                }
            const u16* ck = (const u16*)(ws + WS_CKB) + ((size_t)b * 256 + r) * 512 + 64 * hd + 8 * h;
            const u16* cv = (const u16*)(ws + WS_VCB) + ((size_t)(b * 8 + hd) * 64 + r) * 256 + 4 * h;
            for (int kt = 0; kt < 8; ++kt) attn_tile<0>(st, qf, ck + (size_t)kt * 32 * 512, cv + kt * 32, (size_t)32 * 256, h, mk);
            outp = (u16*)(ws + WS_YB) + (tok0 + rq * 64 + c0q + r) * 512 + 64 * hd;
        } else if (it < N_ITEMS_LB + N_ITEMS_LA) {
            const int i2 = it - N_ITEMS_LB, b = i2 >> 8, hd = (i2 >> 5) & 7, qt = i2 & 31, kvh = hd >> 2;
            const size_t tok0 = (size_t)NCTX + b * 1024;
            const u16* qp = QKV + (tok0 + qt * 32 + r) * QKV_P + 64 * hd + 8 * h;
#pragma unroll
            for (int t = 0; t < 4; ++t) qf[t] = *(const bf16x8*)(qp + 16 * t);
            st.m = a.in[I_SINK][hd]; st.l = h == 0 ? 1.f : 0.f;
            const u16* vtb = (const u16*)(ws + WS_VTA_LAT) + ((size_t)(b * 2 + kvh) * 64 + r) * 1024 + 4 * h;
            const int k_lo = max(qt - 4, 0), k_hi = min(qt + 4, 31);
            for (int kt = k_lo; kt <= k_hi; ++kt) {
                mk.dq = (qt - kt) * 32 + r;
                attn_tile<1>(st, qf, QKV + (tok0 + kt * 32 + r) * QKV_P + 512 + 64 * kvh + 8 * h, vtb + kt * 32, (size_t)32 * 1024, h, mk);
            }
            const u16* ck = (const u16*)(ws + WS_CKA) + ((size_t)b * 256 + r) * 128 + 64 * kvh + 8 * h;
            const u16* cv = (const u16*)(ws + WS_VCA) + ((size_t)(b * 2 + kvh) * 64 + r) * 256 + 4 * h;
            for (int kt = 0; kt < 8; ++kt) attn_tile<0>(st, qf, ck + (size_t)kt * 32 * 128, cv + kt * 32, (size_t)32 * 256, h, mk);
            outp = (u16*)(ws + WS_YA) + (tok0 + qt * 32 + r) * 512 + 64 * hd;
        } else {
            const int i3 = it - N_ITEMS_LB - N_ITEMS_LA, b = i3 >> 7, hh = (i3 >> 3) & 15, qt = i3 & 7;
            const size_t tok0 = (size_t)b * 256;
            const u16 *qp, *kp, *vp;
            if (hh < 8) { const int hd = hh, kvh = hd >> 2;
                qp = QKV + (tok0 + qt * 32 + r) * QKV_P + 64 * hd + 8 * h; kp = QKV + (tok0 + r) * QKV_P + 512 + 64 * kvh + 8 * h;
                vp = (const u16*)(ws + WS_VTA_CTX) + ((size_t)(b * 2 + kvh) * 64 + r) * 256 + 4 * h;
                st.m = a.in[I_SINK][hd]; st.l = h == 0 ? 1.f : 0.f;
                outp = (u16*)(ws + WS_YA) + (tok0 + qt * 32 + r) * 512 + 64 * hd;
            } else { const int hd = hh - 8;
                qp = QKV + (tok0 + qt * 32 + r) * QKV_P + 768 + 64 * hd + 8 * h; kp = QKV + (tok0 + r) * QKV_P + 1280 + 64 * hd + 8 * h;
                vp = (const u16*)(ws + WS_VTB_CTX) + ((size_t)(b * 8 + hd) * 64 + r) * 256 + 4 * h;
                outp = (u16*)(ws + WS_YB) + (tok0 + qt * 32 + r) * 512 + 64 * hd;
            }
#pragma unroll
            for (int t = 0; t < 4; ++t) qf[t] = *(const bf16x8*)(qp + 16 * t);
            for (int kt = 0; kt < 8; ++kt) attn_tile<0>(st, qf, kp + (size_t)kt * 32 * QKV_P, vp + kt * 32, (size_t)32 * 256, h, mk);
        }
        const float l = st.l + __shfl_xor(st.l, 32), inv = 1.f / l;
#pragma unroll
        for (int g = 0; g < 4; ++g) {
            u32x2 o; o.x = pk2(st.o0[4 * g] * inv, st.o0[4 * g + 1] * inv); o.y = pk2(st.o0[4 * g + 2] * inv, st.o0[4 * g + 3] * inv);
            *(u32x2*)(outp + 8 * g + 4 * h) = o;
            o.x = pk2(st.o1[4 * g] * inv, st.o1[4 * g + 1] * inv); o.y = pk2(st.o1[4 * g + 2] * inv, st.o1[4 * g + 3] * inv);
            *(u32x2*)(outp + 32 + 8 * g + 4 * h) = o;
        }
    }
}
constexpr int N_PHASES = 9;
__global__ void __launch_bounds__(512, 2) fwd_mega(Args args) {
    extern __shared__ __attribute__((aligned(16))) unsigned char lds_raw[];
    LAS unsigned char* lds = (LAS unsigned char*)lds_raw;
    cg::grid_group grid = cg::this_grid();
    const int lo = args.ph_lo, hi = args.ph_hi;
    unsigned char* ws = args.ws;
#ifndef PHASE_MASK
#define PHASE_MASK 0x1ff
#endif
#define IN(k) (((PHASE_MASK >> (k)) & 1) && lo <= (k) && (k) < hi)
#define SEAM(k) do { if (IN(k) && IN((k) + 1)) grid.sync(); } while (0)
    if (IN(0)) { p0_prologue(args, lds); }
    SEAM(0);
    if (IN(1)) { norm_mod_phase(args, 0); }
    SEAM(1);
    if (IN(2)) {
        pg8::Gemm g{(const pg8::bf16_t*)(ws + WS_H), (const pg8::bf16_t*)(ws + WS_WIN), MTOK, DIN, DM}; pg8::StaticOrder S; S.init(MTOK, DIN, gridDim.x, blockIdx.x);
        EpiIn E{&args};
        pg8::gemm_phase<EpiIn, pg8::StaticOrder, true, true>(lds, g, S, E);
    }
    SEAM(2);
    if (IN(3)) { attn_phase(args); }
    SEAM(3);
    if (IN(4)) {
        pg8::StaticOrder S; S.init(MTOK, DM, gridDim.x, blockIdx.x);
        { pg8::Gemm g{(const pg8::bf16_t*)(ws + WS_YA), (const pg8::bf16_t*)(ws + WS_WOA), MTOK, DM, 512}; EpiGate<0> E{&args};
          pg8::gemm_phase<EpiGate<0>, pg8::StaticOrder, true, true>(lds, g, S, E); }
        { pg8::Gemm g{(const pg8::bf16_t*)(ws + WS_YB), (const pg8::bf16_t*)(ws + WS_WOB), MTOK, DM, 512}; EpiGate<1> E{&args};
          pg8::gemm_phase<EpiGate<1>, pg8::StaticOrder, true, true>(lds, g, S, E); }
    }
    SEAM(4);
    if (IN(5)) {
        pg8::Gemm g{(const pg8::bf16_t*)(ws + WS_T), (const pg8::bf16_t*)(ws + WS_WO), MTOK, DM, DM}; pg8::StaticOrder S; S.init(MTOK, DM, gridDim.x, blockIdx.x);
        EpiRes<0> E{&args};
        pg8::gemm_phase<EpiRes<0>, pg8::StaticOrder, true, true>(lds, g, S, E);
    }
    SEAM(5);
    if (IN(6)) { norm_mod_phase(args, 1); }
    SEAM(6);
    if (IN(7)) {
        pg8::Gemm g{(const pg8::bf16_t*)(ws + WS_H), (const pg8::bf16_t*)(ws + WS_WGU), MTOK, NGU, DM}; pg8::StaticOrder S; S.init(MTOK, NGU, gridDim.x, blockIdx.x);
        EpiSwiglu E{&args};
        pg8::gemm_phase<EpiSwiglu, pg8::StaticOrder, true, true>(lds, g, S, E);
    }
    SEAM(7);
    if (IN(8)) {
        pg8::Gemm g{(const pg8::bf16_t*)(ws + WS_GU), (const pg8::bf16_t*)(ws + WS_WD), MTOK, DM, DFF}; pg8::StaticOrder S; S.init(MTOK, DM, gridDim.x, blockIdx.x);
        EpiRes<1> E{&args};
        pg8::gemm_phase<EpiRes<1>, pg8::StaticOrder, true, true>(lds, g, S, E);
    }
#undef IN
#undef SEAM
}

#ifndef N_LAUNCH_MODE
#define N_LAUNCH_MODE 9
#endif
extern "C" void kernel_launch(void* const* d_in, const int* in_sizes, int n_in, void* d_out, int out_size, void* d_ws, size_t ws_size, hipStream_t stream) {
    static int grid = 0;
    if (grid == 0) {
        int dev = 0, cus = 0, per_cu = 0;
        (void)hipGetDevice(&dev);
        (void)hipDeviceGetAttribute(&cus, hipDeviceAttributeMultiprocessorCount, dev);
        (void)hipFuncSetAttribute((const void*)fwd_mega, hipFuncAttributeMaxDynamicSharedMemorySize, LDS_BYTES);
        (void)hipOccupancyMaxActiveBlocksPerMultiprocessor(&per_cu, (const void*)fwd_mega, 512, LDS_BYTES);
        if (per_cu < 1) { fprintf(stderr, "occupancy query says %d blocks/CU\n", per_cu); per_cu = 1; }
        grid = cus * per_cu;
        if (n_in != 25) fprintf(stderr, "kernel_launch: expected 25 inputs, got %d\n", n_in);
    }
    (void)hipMemsetAsync((char*)d_ws + WS_CTL, 0, CTL_BYTES, stream);
    Args a{};
    for (int i = 0; i < 25; ++i) a.in[i] = (const float*)d_in[i];
    a.out = (float*)d_out; a.ws = (unsigned char*)d_ws;
    if (N_LAUNCH_MODE == 1) {
        a.ph_lo = 0; a.ph_hi = N_PHASES;
        void* kargs[] = {&a};
        hipError_t e = hipLaunchCooperativeKernel((const void*)fwd_mega, dim3(grid), dim3(512), kargs, LDS_BYTES, stream);
        if (e != hipSuccess) fprintf(stderr, "cooperative launch failed: %s (grid %d)\n", hipGetErrorString(e), grid);
    } else {
        for (int p = 0; p < N_PHASES; ++p) { a.ph_lo = p; a.ph_hi = p + 1; hipLaunchKernelGGL(fwd_mega, dim3(grid), dim3(512), LDS_BYTES, stream, a); }
    }
}
```

```cpp
#include <hip/hip_runtime.h>
#include <hip/hip_cooperative_groups.h>
#include <cstdio>
#include <cstdint>
namespace cg = cooperative_groups;
namespace pg8 {
#define PG8_LAS __attribute__((address_space(3)))
typedef unsigned short bf16_t;
typedef short bf16x8 __attribute__((ext_vector_type(8)));
typedef float f32x4 __attribute__((ext_vector_type(4)));
typedef unsigned u32x4 __attribute__((ext_vector_type(4)));
constexpr int BM = 256, BK = 64, HALF = 128, HTB = HALF * BK * 2  , STAGE_BYTES = 8 * HTB, NXCD = 8, WGM = 8;

__host__ __device__ __forceinline__ int lds_byte(int r, int c) { const int st = (r >> 4) * 2 + (c >> 5), rr = r & 15, cc = c & 31, ob = rr * 64 + cc * 2; return st * 1024 + (ob ^ (((ob >> 9) & 1) << 5)); }
__host__ __device__ __forceinline__ void stage_rc(int b, int& R, int& C) { const int st = b / 1024, sb = b % 1024, swz = sb ^ (((sb >> 9) & 1) << 5); R = (st >> 1) * 16 + swz / 64; C = (st & 1) * 32 + (swz % 64) / 2; }
__host__ __device__ __forceinline__ int perm32(int rho) { const int n = rho >> 4, i = rho & 15; return 8 * (i >> 2) + 4 * n + (i & 3); }

struct Unit { int pm, pn; };
struct Gemm { const bf16_t* A; const bf16_t* Bt; int M, N, K; };

struct StaticOrder {
    int nM, nN, nwg, G, c;
    __host__ __device__ void init(int M, int N, int G_, int c_) { nM = M / BM; nN = N / BM; nwg = nM * nN; G = G_; c = c_; }
    __host__ __device__ bool next(int i, Unit& u) const {
        const long L = (long)i * G + c; if (L >= nwg) return false;
        int wgid = (int)L; { const int q = nwg / NXCD, r = nwg % NXCD, xcd = wgid % NXCD, off = wgid / NXCD; wgid = (xcd < r ? xcd * (q + 1) : r * (q + 1) + (xcd - r) * q) + off; }
        const int nig = WGM * nN, gid = wgid / nig, fm = gid * WGM, gsz = (nM - fm) < WGM ? (nM - fm) : WGM;
        u.pm = fm + ((wgid % nig) % gsz); u.pn = (wgid % nig) / gsz; return true;
    }
    __device__ __forceinline__ void a_ready(const Unit&) const {}
    __device__ __forceinline__ void done(const Unit&) const {}
};

__device__ __forceinline__ unsigned cvt_pk_bf16(float lo, float hi) { unsigned r; asm volatile("v_cvt_pk_bf16_f32 %0, %1, %2" : "=v"(r) : "v"(lo), "v"(hi)); return r; }

template <class Epi, class Sched, bool ALIGN_EPI = false, bool SP2 = false>
__device__ __forceinline__ void gemm_phase(PG8_LAS unsigned char* lds, const Gemm g, const Sched& S, const Epi& E) {
    const int tid = threadIdx.x, wid = __builtin_amdgcn_readfirstlane(tid >> 6), lane = tid & 63, wr = wid >> 2, wc = wid & 3, fr = lane & 15, fq = lane >> 4;
    const int K = g.K, nt = K / BK;
    unsigned voffA[2], voffB[2];
#pragma unroll
    for (int i = 0; i < 2; ++i) { int R, C; stage_rc(tid * 16 + i * 8192, R, C); const int Rb = Epi::PERM ? ((R & ~31) + perm32(R & 31)) : R;
        voffA[i] = (unsigned)(R * K + C) * 2u; voffB[i] = (unsigned)(Rb * K + C) * 2u; }
    const size_t kstep = (size_t)(BK * 2);
    const size_t hstep = (size_t)HALF * K * 2;
    const size_t tstep = 2 * hstep;
    const unsigned ldsw = (unsigned)wid * 1024u;
    const int aoff = lds_byte(wr * 64 + fr, fq * 8), boff = lds_byte(wc * 32 + fr, fq * 8);
#define PG8_SA(b, h) (((b) * 2 + (h)) * HTB)
#define PG8_SB(b, h) ((4 + (b) * 2 + (h)) * HTB)
#define PG8_STAGE(bufoff, gbase, voff) do { _Pragma("unroll") for (int _i = 0; _i < 2; ++_i) \
        __builtin_amdgcn_global_load_lds((const unsigned*)((const char*)(gbase) + (voff)[_i]), (PG8_LAS unsigned*)(lds + (bufoff) + ldsw + _i * 8192), 16, 0, 0); } while (0)
#define PG8_LDA(dst, b, h) do { _Pragma("unroll") for (int m = 0; m < 4; ++m) _Pragma("unroll") for (int k = 0; k < 2; ++k) dst[m][k] = *(const PG8_LAS bf16x8*)(lds + PG8_SA(b, h) + aoff + m * 2048 + k * 1024); } while (0)
#define PG8_LDB(dst, b, h) do { _Pragma("unroll") for (int n = 0; n < 2; ++n) _Pragma("unroll") for (int k = 0; k < 2; ++k) dst[n][k] = *(const PG8_LAS bf16x8*)(lds + PG8_SB(b, h) + boff + n * 2048 + k * 1024); } while (0)
#define PG8_MMA(ai, bj, At, Bt) do { __builtin_amdgcn_s_setprio(1); _Pragma("unroll") for (int m = 0; m < 4; ++m) _Pragma("unroll") for (int n = 0; n < 2; ++n) _Pragma("unroll") for (int k = 0; k < 2; ++k) \
        acc[ai][bj][m][n] = __builtin_amdgcn_mfma_f32_16x16x32_bf16(Bt[n][k], At[m][k], acc[ai][bj][m][n], 0, 0, 0); __builtin_amdgcn_s_setprio(0); } while (0)
#define PG8_WAIT_V(n) asm volatile("s_waitcnt vmcnt(" #n ")" ::: "memory")
#define PG8_WAIT_L(n) asm volatile("s_waitcnt lgkmcnt(" #n ")" ::: "memory")
#define PG8_BAR __builtin_amdgcn_s_barrier()
#define PG8_SCHED __builtin_amdgcn_sched_barrier(0)
    Unit cur, nxt; int ui = 0;
    if (!S.next(0, cur)) return;
    f32x4 acc[2][2][4][2];
#pragma unroll
    for (int a = 0; a < 2; ++a)
#pragma unroll
        for (int b = 0; b < 2; ++b)
#pragma unroll
            for (int m = 0; m < 4; ++m)
#pragma unroll
                for (int n = 0; n < 2; ++n) acc[a][b][m][n] = (f32x4){0.f, 0.f, 0.f, 0.f};
    bf16x8 At[4][2], B0[2][2], B1[2][2];
    const char* cA = (const char*)g.A + (size_t)cur.pm * tstep; const char* cB = (const char*)g.Bt + (size_t)cur.pn * tstep;
    S.a_ready(cur);
    if constexpr (SP2) {
        PG8_STAGE(PG8_SB(0, 0), cB, voffB); PG8_STAGE(PG8_SB(0, 1), cB + hstep, voffB); PG8_STAGE(PG8_SA(0, 0), cA, voffA); PG8_STAGE(PG8_SA(0, 1), cA + hstep, voffA);
        if (wr == 1) PG8_BAR;
        PG8_WAIT_V(2); PG8_BAR;
        PG8_STAGE(PG8_SB(1, 0), cB + kstep, voffB); PG8_STAGE(PG8_SA(1, 0), cA + kstep, voffA); PG8_STAGE(PG8_SB(1, 1), cB + hstep + kstep, voffB);
        PG8_WAIT_V(6); PG8_BAR;
    } else {
        PG8_STAGE(PG8_SB(0, 0), cB, voffB); PG8_STAGE(PG8_SA(0, 0), cA, voffA); PG8_STAGE(PG8_SB(0, 1), cB + hstep, voffB); PG8_STAGE(PG8_SA(0, 1), cA + hstep, voffA);
        if (wr == 1) PG8_BAR;
        PG8_WAIT_V(4); PG8_BAR;
        PG8_STAGE(PG8_SB(1, 0), cB + kstep, voffB); PG8_STAGE(PG8_SA(1, 0), cA + kstep, voffA); PG8_STAGE(PG8_SB(1, 1), cB + hstep + kstep, voffB);
        PG8_WAIT_V(6); PG8_BAR;
    }
    for (;;) {
        const bool has_next = S.next(ui + 1, nxt);
        const char* nA = has_next ? (const char*)g.A + (size_t)nxt.pm * tstep : cA; const char* nB = has_next ? (const char*)g.Bt + (size_t)nxt.pn * tstep : cB;
        for (int t = 0; t < nt; t += 2) {
            const bool last = (t == nt - 2);
            const char* a1 = cA + (size_t)(t + 1) * kstep;
            const char* a2 = last ? nA : cA + (size_t)(t + 2) * kstep; const char* b2 = last ? nB : cB + (size_t)(t + 2) * kstep;
            const char* a3 = a2 + kstep; const char* b3 = b2 + kstep;
            if (last && has_next) S.a_ready(nxt);
            if constexpr (SP2) {
            PG8_LDB(B0, 0, 0); PG8_LDB(B1, 0, 1); PG8_SCHED; PG8_LDA(At, 0, 0); PG8_STAGE(PG8_SA(1, 1), a1 + hstep, voffA);
            PG8_WAIT_V(8); PG8_WAIT_L(0); PG8_BAR; PG8_MMA(0, 0, At, B0); PG8_MMA(0, 1, At, B1); PG8_BAR; PG8_SCHED;
            PG8_LDA(At, 0, 1); PG8_STAGE(PG8_SB(0, 0), b2, voffB); PG8_STAGE(PG8_SB(0, 1), b2 + hstep, voffB); PG8_STAGE(PG8_SA(0, 0), a2, voffA);
            PG8_WAIT_V(8); PG8_WAIT_L(0); PG8_BAR; PG8_MMA(1, 0, At, B0); PG8_MMA(1, 1, At, B1); PG8_BAR; PG8_SCHED;
            PG8_LDB(B0, 1, 0); PG8_LDB(B1, 1, 1); PG8_SCHED; PG8_LDA(At, 1, 0); PG8_STAGE(PG8_SA(0, 1), a2 + hstep, voffA);
            PG8_WAIT_V(8); PG8_WAIT_L(0); PG8_BAR; PG8_MMA(0, 0, At, B0); PG8_MMA(0, 1, At, B1); PG8_BAR; PG8_SCHED;
            PG8_LDA(At, 1, 1); PG8_STAGE(PG8_SB(1, 0), b3, voffB); PG8_STAGE(PG8_SB(1, 1), b3 + hstep, voffB); PG8_STAGE(PG8_SA(1, 0), a3, voffA);
            PG8_WAIT_V(8); PG8_WAIT_L(0); PG8_BAR; PG8_MMA(1, 0, At, B0); PG8_MMA(1, 1, At, B1); PG8_BAR; PG8_SCHED;
            } else {
            PG8_LDB(B0, 0, 0); PG8_SCHED; PG8_LDA(At, 0, 0); PG8_STAGE(PG8_SA(1, 1), a1 + hstep, voffA);
            PG8_WAIT_L(8); PG8_BAR; PG8_WAIT_L(0); PG8_MMA(0, 0, At, B0); PG8_BAR; PG8_SCHED;
            PG8_LDB(B1, 0, 1); PG8_STAGE(PG8_SB(0, 0), b2, voffB);
            PG8_BAR; PG8_WAIT_L(0); PG8_MMA(0, 1, At, B1); PG8_BAR;
            PG8_LDA(At, 0, 1); PG8_STAGE(PG8_SA(0, 0), a2, voffA);
            PG8_BAR; PG8_WAIT_L(0); PG8_MMA(1, 0, At, B0); PG8_BAR; PG8_SCHED;
            PG8_STAGE(PG8_SB(0, 1), b2 + hstep, voffB);
            PG8_WAIT_V(6); PG8_BAR; PG8_MMA(1, 1, At, B1); PG8_BAR;
            PG8_LDB(B0, 1, 0); PG8_SCHED; PG8_LDA(At, 1, 0); PG8_STAGE(PG8_SA(0, 1), a2 + hstep, voffA);
            PG8_WAIT_L(8); PG8_BAR; PG8_WAIT_L(0); PG8_MMA(0, 0, At, B0); PG8_BAR; PG8_SCHED;
            PG8_LDB(B1, 1, 1); PG8_STAGE(PG8_SB(1, 0), b3, voffB);
            PG8_BAR; PG8_WAIT_L(0); PG8_MMA(0, 1, At, B1); PG8_BAR;
            PG8_LDA(At, 1, 1); PG8_STAGE(PG8_SA(1, 0), a3, voffA);
            PG8_BAR; PG8_WAIT_L(0); PG8_MMA(1, 0, At, B0); PG8_BAR; PG8_SCHED;
            PG8_STAGE(PG8_SB(1, 1), b3 + hstep, voffB);
            PG8_WAIT_V(6); PG8_BAR; PG8_MMA(1, 1, At, B1); PG8_BAR;
            }
        }
        if constexpr (ALIGN_EPI) { if (wr == 0) PG8_BAR; }
        if constexpr (!Epi::AFTER_DRAIN) { E(acc, cur, wr, wc, fr, fq); S.done(cur); }
        if (!has_next) break;
#pragma unroll
        for (int a = 0; a < 2; ++a)
#pragma unroll
            for (int b = 0; b < 2; ++b)
#pragma unroll
                for (int m = 0; m < 4; ++m)
#pragma unroll
                    for (int n = 0; n < 2; ++n) acc[a][b][m][n] = (f32x4){0.f, 0.f, 0.f, 0.f};
        cur = nxt; cA = nA; cB = nB; ++ui;
        if constexpr (ALIGN_EPI) { if (wr == 1) PG8_BAR; }
    }
    PG8_WAIT_V(0);
    if constexpr (!ALIGN_EPI) { if (wr == 0) PG8_BAR; }
    PG8_BAR;
    if constexpr (Epi::AFTER_DRAIN) { E.fused(acc, cur, wr, wc, fr, fq, lds, wid, lane); S.done(cur); }
#undef PG8_SA
#undef PG8_SB
#undef PG8_STAGE
#undef PG8_LDA
#undef PG8_LDB
#undef PG8_MMA
#undef PG8_WAIT_V
#undef PG8_WAIT_L
#undef PG8_BAR
#undef PG8_SCHED
}
}

#define DI __device__ __forceinline__
#define LAS __attribute__((address_space(3)))
typedef unsigned short u16;
typedef float f32x4 __attribute__((ext_vector_type(4)));
typedef float f32x16 __attribute__((ext_vector_type(16)));
typedef float f32x2 __attribute__((ext_vector_type(2)));
typedef short bf16x8 __attribute__((ext_vector_type(8)));
typedef short s16x4 __attribute__((ext_vector_type(4)));
typedef unsigned u32x2 __attribute__((ext_vector_type(2)));
typedef unsigned u32x4 __attribute__((ext_vector_type(4)));
typedef __bf16 bf16x2_t __attribute__((ext_vector_type(2)));

constexpr int DM = 1024, NCTX = 8192, NLAT = 2048, MTOK = 10240, DIN = 4352, DFF = 2816, NGU = 2 * DFF;
constexpr int QKV_P = 2304, G_P = 2048;
constexpr size_t MiB = 1u << 20;
constexpr size_t WS_CTL = 0, CTL_BYTES = 128 * 1024, CTL_QUEUE = 81920;
constexpr size_t WS_ROPE = 512 * 1024;
constexpr size_t WS_WIN = 1 * MiB, WS_WOA = 10 * MiB, WS_WOB = 11 * MiB, WS_WO = 12 * MiB, WS_WGU = 14 * MiB, WS_WD = 25 * MiB;
constexpr size_t WS_CKA = 31 * MiB, WS_CKB = 31 * MiB + 128 * 1024, WS_VCA = 32 * MiB, WS_VCB = 32 * MiB + 128 * 1024;
constexpr size_t WS_VTA_CTX = 33 * MiB, WS_VTB_CTX = 35 * MiB, WS_VTA_LAT = 43 * MiB, WS_VTB_LAT = 44 * MiB;
constexpr size_t WS_H = 46 * MiB, WS_QKV = 66 * MiB, WS_G = 111 * MiB, WS_YA = 151 * MiB, WS_YB = 161 * MiB, WS_TMP = 171 * MiB, WS_T = 211 * MiB, WS_GU = 66 * MiB;
constexpr size_t OUT_Y = 0, OUT_AK = 10485760, OUT_AV = 11534336, OUT_BK = 12582912, OUT_BV = 16777216;
constexpr int LDS_BYTES = 147456;
constexpr float RMS_EPS = 1e-6f;

DI unsigned pk2(float lo, float hi) { f32x2 v = {lo, hi}; bf16x2_t b = __builtin_convertvector(v, bf16x2_t); return __builtin_bit_cast(unsigned, b); }
DI u16 bf1(float x) { return (u16)(pk2(x, 0.f) & 0xffffu); }
DI float wave_sum(float v) {
#pragma unroll
    for (int o = 1; o < 64; o <<= 1) v += __shfl_xor(v, o);
    return v;
}
DI float sigmoidf_(float x) { return 1.0f / (1.0f + __expf(-x)); }
DI float siluf_(float x) { return x / (1.0f + __expf(-x)); }

struct Args { const float* in[25]; float* out; unsigned char* ws; int ph_lo, ph_hi; };
enum { I_XP = 0, I_XS, I_CAK, I_CAV, I_CBK, I_CBV, I_C, I_CCTX, I_WADA, I_BADA, I_GATTN, I_WIN, I_QNA, I_KNA, I_QNB, I_KNB, I_SINK, I_RPB, I_WOA, I_WOB, I_WO, I_GFFN, I_WG, I_WU, I_WD };

DI int dest_row(int mode, int n) {
    if (mode == 0) return n;
    if (mode == 1) { const int pn = n >> 8, wc = (n >> 6) & 3, bj = (n >> 5) & 1, e = n & 31; return (pn << 8) + (bj << 7) + (wc << 5) + e; }
    const int pn = n >> 7, rem = n & 127, bj = rem >> 6, wc = (rem >> 4) & 3, e = rem & 15;
    return (pn << 8) + (bj << 7) + (wc << 5) + ((mode == 3) ? 16 : 0) + e;
}
DI void p0_transpose_item(const float* W, int K, int N, u16* WT, int mode, LAS float* scr, int item, int lane) {
    const int nblk = N / 32, kb = item / nblk, nb = item % nblk, k0 = 64 * kb, n0 = 32 * nb;
#pragma unroll 8
    for (int i = 0; i < 32; ++i) { const int kk = 2 * i + (lane >> 5); scr[kk * 33 + (lane & 31)] = W[(size_t)(k0 + kk) * N + n0 + (lane & 31)]; }
    asm volatile("s_waitcnt lgkmcnt(0)" ::: "memory");
    const int c = lane & 7;
#pragma unroll
    for (int j = 0; j < 4; ++j) { const int n = (lane >> 3) + 8 * j; const LAS float* s = scr + (8 * c) * 33 + n;
        u32x4 o; o.x = pk2(s[0 * 33], s[1 * 33]); o.y = pk2(s[2 * 33], s[3 * 33]); o.z = pk2(s[4 * 33], s[5 * 33]); o.w = pk2(s[6 * 33], s[7 * 33]);
        *(u32x4*)(WT + (size_t)dest_row(mode, n0 + n) * K + k0 + 8 * c) = o; }
    asm volatile("s_waitcnt lgkmcnt(0)" ::: "memory");
}

DI void p0_prologue(const Args& a, LAS unsigned char* lds) {
    const int tid = threadIdx.x, lane = tid & 63, wave = __builtin_amdgcn_readfirstlane(tid >> 6);
    const int gw = blockIdx.x * 8 + wave, NGW = gridDim.x * 8;
    unsigned char* ws = a.ws;
    LAS float* scr = (LAS float*)(lds + wave * 16384);
    float* ada = (float*)(ws + WS_CTL);
    for (int it = gw; it < 24 * 32; it += NGW) {
        const int cgp = it % 24, kc = it / 24, col = cgp * 256 + 4 * lane;
        const float* wp = a.in[I_WADA] + (size_t)(kc * 32) * 6144 + col;
        f32x4 acc0 = {0, 0, 0, 0}, acc1 = acc0, acc2 = acc0;
#pragma unroll 8
        for (int k = 0; k < 32; ++k) {
            const f32x4 w = *(const f32x4*)(wp + (size_t)k * 6144);
            const int kk = kc * 32 + k;
            const float s0 = siluf_(a.in[I_CCTX][kk]), s1 = siluf_(a.in[I_C][kk]), s2 = siluf_(a.in[I_C][1024 + kk]);
            acc0 += w * s0; acc1 += w * s1; acc2 += w * s2;
        }
        if (kc == 0) { const f32x4 b = *(const f32x4*)(a.in[I_BADA] + col); acc0 += b; acc1 += b; acc2 += b; }
#pragma unroll
        for (int j = 0; j < 4; ++j) { atomicAdd(ada + col + j, acc0[j]); atomicAdd(ada + 6144 + col + j, acc1[j]); atomicAdd(ada + 12288 + col + j, acc2[j]); }
    }
    constexpr int I_IN = 16 * (DIN / 32), I_OA = 8 * 32, I_OB = 8 * 32, I_O = 16 * 32, I_G = 16 * (DFF / 32), I_U = I_G, I_D = (DFF / 64) * 32;
    constexpr int NITEMS = I_IN + I_OA + I_OB + I_O + I_G + I_U + I_D;
    for (int it = gw; it < NITEMS; it += NGW) {
        int r = it;
        if (r < I_IN) { p0_transpose_item(a.in[I_WIN], DM, DIN, (u16*)(ws + WS_WIN), 1, scr, r, lane); continue; } r -= I_IN;
        if (r < I_OA) { p0_transpose_item(a.in[I_WOA], 512, DM, (u16*)(ws + WS_WOA), 0, scr, r, lane); continue; } r -= I_OA;
        if (r < I_OB) { p0_transpose_item(a.in[I_WOB], 512, DM, (u16*)(ws + WS_WOB), 0, scr, r, lane); continue; } r -= I_OB;
        if (r < I_O) { p0_transpose_item(a.in[I_WO], DM, DM, (u16*)(ws + WS_WO), 0, scr, r, lane); continue; } r -= I_O;
        if (r < I_G) { p0_transpose_item(a.in[I_WG], DM, DFF, (u16*)(ws + WS_WGU), 2, scr, r, lane); continue; } r -= I_G;
        if (r < I_U) { p0_transpose_item(a.in[I_WU], DM, DFF, (u16*)(ws + WS_WGU), 3, scr, r, lane); continue; } r -= I_U;
        p0_transpose_item(a.in[I_WD], DFF, DM, (u16*)(ws + WS_WD), 0, scr, r, lane);
    }
    if (blockIdx.x == 0) { for (int i = tid; i < 64 * 16; i += 512) { const int pos = i >> 4, fi = i & 15; const float ang = (float)pos * exp2f(-(float)fi * (13.287712379549449f / 16.0f));
        float* rt = (float*)(ws + WS_ROPE) + (pos * 4 + (fi >> 2)) * 8 + (fi & 3); rt[0] = cosf(ang); rt[4] = sinf(ang); } }
    const int gt = blockIdx.x * 512 + tid, NGT = gridDim.x * 512;
    for (int i = gt; i < 2 * 256 * 128; i += NGT) {
        ((u16*)(ws + WS_CKA))[i] = bf1(a.in[I_CAK][i]);
        const int d = i & 63, hd = (i >> 6) & 1, key = (i >> 7) & 255, b = i >> 15;
        ((u16*)(ws + WS_VCA))[((b * 2 + hd) * 64 + d) * 256 + key] = bf1(a.in[I_CAV][i]);
    }
    for (int i = gt; i < 2 * 256 * 512; i += NGT) {
        ((u16*)(ws + WS_CKB))[i] = bf1(a.in[I_CBK][i]);
        const int d = i & 63, hd = (i >> 6) & 7, key = (i >> 9) & 255, b = i >> 17;
        ((u16*)(ws + WS_VCB))[((b * 8 + hd) * 64 + d) * 256 + key] = bf1(a.in[I_CBV][i]);
    }
}

DI void norm_mod_phase(const Args& a, int which) {
    const int tid = threadIdx.x, lane = tid & 63, wave = tid >> 6;
    const int gw = blockIdx.x * 8 + wave, NGW = gridDim.x * 8;
    const float* ada = (const float*)(a.ws + WS_CTL);
    const float* g = a.in[which ? I_GFFN : I_GATTN];
    u16* H = (u16*)(a.ws + WS_H);
    for (int r = gw; r < MTOK; r += NGW) {
        const float* xrow = which ? (a.out + OUT_Y + (size_t)r * DM) : (r < NCTX ? a.in[I_XP] + (size_t)r * DM : a.in[I_XS] + (size_t)(r - NCTX) * DM);
        const int grp = r < NCTX ? 0 : 1 + ((r - NCTX) >> 10);
        const float* sh = ada + grp * 6144 + (which ? 3072 : 0);
        const float* sc = sh + 1024;
        f32x4 v[4]; float ss = 0.f;
#pragma unroll
        for (int j = 0; j < 4; ++j) { v[j] = *(const f32x4*)(xrow + 4 * lane + 256 * j); ss += (v[j].x * v[j].x + v[j].y * v[j].y) + (v[j].z * v[j].z + v[j].w * v[j].w); }
        const float rstd = rsqrtf(wave_sum(ss) * (1.f / DM) + RMS_EPS);
#pragma unroll
        for (int j = 0; j < 4; ++j) {
            const int c = 4 * lane + 256 * j;
            const f32x4 gg = *(const f32x4*)(g + c), s1 = *(const f32x4*)(sc + c), s0 = *(const f32x4*)(sh + c);
            const f32x4 y = (v[j] * rstd * gg) * (s1 + 1.0f) + s0;
            u32x2 o; o.x = pk2(y.x, y.y); o.y = pk2(y.z, y.w);
            *(u32x2*)(H + (size_t)r * DM + c) = o;
        }
    }
}
typedef const pg8::f32x4 (&AccRef)[2][2][4][2];

struct EpiIn {
    static constexpr bool PERM = false, AFTER_DRAIN = false;
    const Args* a;
    DI void operator()(AccRef acc, const pg8::Unit& u, int wr, int wc, int fr, int fq) const {
        asm volatile("" : "+v"(fr), "+v"(fq));
        unsigned char* ws = a->ws;
        const int pn = u.pn, pm = u.pm;
        const bool lat = pm >= 32;
        const int row0 = pm * 256 + wr * 64 + fr;
        if (pn >= 9) {
            u16* G = (u16*)(ws + WS_G);
#pragma unroll
            for (int ai = 0; ai < 2; ++ai)
#pragma unroll
                for (int m = 0; m < 4; ++m) { u16* rp = G + (size_t)(row0 + ai * 128 + m * 16) * G_P + (pn - 9) * 256 + wc * 64 + 4 * fq;
#pragma unroll
                    for (int bj = 0; bj < 2; ++bj)
#pragma unroll
                        for (int n = 0; n < 2; ++n) { const pg8::f32x4 v = acc[ai][bj][m][n]; u32x2 o; o.x = pk2(sigmoidf_(v[0]), sigmoidf_(v[1])); o.y = pk2(sigmoidf_(v[2]), sigmoidf_(v[3]));
                            *(u32x2*)(rp + 32 * bj + 16 * n) = o; } }
            return;
        }
        const bool isv = (pn == 2 && wc >= 2) || pn == 7 || pn == 8;
        if (isv) {
            int nh, hd; u16* vt; float* ov;
            if (pn == 2) { nh = 2; hd = wc - 2; vt = (u16*)(ws + (lat ? WS_VTA_LAT : WS_VTA_CTX)); ov = a->out + OUT_AV; }
            else { nh = 8; hd = (pn - 7) * 4 + wc; vt = (u16*)(ws + (lat ? WS_VTB_LAT : WS_VTB_CTX)); ov = a->out + OUT_BV; }
            const int Tsh = lat ? 10 : 8;
            const int bb = lat ? (pm - 32) >> 2 : pm;
            const unsigned t0 = (unsigned)((lat ? ((pm - 32) & 3) * 256 : 0) + wr * 64 + fr);
            u16* vb = vt + (((size_t)(bb * nh + hd) * 64) << Tsh);
#pragma unroll
            for (int ai = 0; ai < 2; ++ai)
#pragma unroll
                for (int m = 0; m < 4; ++m) {
#pragma unroll
                    for (int bj = 0; bj < 2; ++bj)
#pragma unroll
                        for (int n = 0; n < 2; ++n) { const pg8::f32x4 v = acc[ai][bj][m][n]; const unsigned d = 32 * bj + 16 * n + 4 * fq;
#pragma unroll
                            for (int j = 0; j < 4; ++j) vb[((d + j) << Tsh) + t0 + ai * 128 + m * 16] = bf1(v[j]);
                            if (!lat) *(pg8::f32x4*)(ov + (unsigned)(((row0 + ai * 128 + m * 16) * nh + hd) * 64) + d) = v; }
                    __builtin_amdgcn_sched_barrier(0); }
            return;
        }
        const float* nw; float* ok = nullptr; int nh = 0, hd = 0; bool rope = false;
        if (pn < 2) { nw = a->in[I_QNA]; rope = lat; }
        else if (pn == 2) { nw = a->in[I_KNA]; rope = lat; ok = a->out + OUT_AK; nh = 2; hd = wc; }
        else if (pn < 5) { nw = a->in[I_QNB]; }
        else { nw = a->in[I_KNB]; ok = a->out + OUT_BK; nh = 8; hd = (pn - 5) * 4 + wc; }
        u16* Q = (u16*)(ws + WS_QKV);
        pg8::f32x4 wv[2][2];
#pragma unroll
        for (int bj = 0; bj < 2; ++bj)
#pragma unroll
            for (int n = 0; n < 2; ++n) wv[bj][n] = *(const pg8::f32x4*)(nw + 32 * bj + 16 * n + 4 * fq);
        const float* rtab = (const float*)(ws + WS_ROPE) + fq * 8;
#pragma unroll
        for (int ai = 0; ai < 2; ++ai)
#pragma unroll
            for (int m = 0; m < 4; ++m) {
                const int r = row0 + ai * 128 + m * 16;
                pg8::f32x4 v[2][2]; float ss = 0.f;
#pragma unroll
                for (int bj = 0; bj < 2; ++bj)
#pragma unroll
                    for (int n = 0; n < 2; ++n) { v[bj][n] = acc[ai][bj][m][n]; ss += (v[bj][n][0] * v[bj][n][0] + v[bj][n][1] * v[bj][n][1]) + (v[bj][n][2] * v[bj][n][2] + v[bj][n][3] * v[bj][n][3]); }
                ss += __shfl_xor(ss, 16); ss += __shfl_xor(ss, 32);
                const float rs = rsqrtf(ss * (1.f / 64.f) + RMS_EPS);
#pragma unroll
                for (int bj = 0; bj < 2; ++bj)
#pragma unroll
                    for (int n = 0; n < 2; ++n) v[bj][n] = v[bj][n] * rs * wv[bj][n];
                if (rope) {
                    const int t = (r - NCTX) & 1023;
#pragma unroll
                    for (int bj = 0; bj < 2; ++bj) { const int pos = (bj == 0 ? (t >> 6) : (t & 63));
                        const pg8::f32x4 cs = *(const pg8::f32x4*)(rtab + pos * 32), sn = *(const pg8::f32x4*)(rtab + pos * 32 + 4);
                        const pg8::f32x4 x1 = v[bj][0], x2 = v[bj][1]; v[bj][0] = x1 * cs - x2 * sn; v[bj][1] = x2 * cs + x1 * sn; }
                }
                u16* rp = Q + (size_t)r * QKV_P + pn * 256 + wc * 64 + 4 * fq;
#pragma unroll
                for (int bj = 0; bj < 2; ++bj)
#pragma unroll
                    for (int n = 0; n < 2; ++n) { u32x2 o; o.x = pk2(v[bj][n][0], v[bj][n][1]); o.y = pk2(v[bj][n][2], v[bj][n][3]); *(u32x2*)(rp + 32 * bj + 16 * n) = o;
                        if (ok && !lat) *(pg8::f32x4*)(ok + ((size_t)r * nh + hd) * 64 + 32 * bj + 16 * n + 4 * fq) = v[bj][n]; }
                __builtin_amdgcn_sched_barrier(0);
            }
    }
};

template <int SECOND> struct EpiGate {
    static constexpr bool PERM = false, AFTER_DRAIN = false;
    const Args* a;
    DI void operator()(AccRef acc, const pg8::Unit& u, int wr, int wc, int fr, int fq) const {
        asm volatile("" : "+v"(fr), "+v"(fq));
        unsigned char* ws = a->ws;
        const u16* G = (const u16*)(ws + WS_G) + (SECOND ? 1024 : 0);
        float* TMP = (float*)(ws + WS_TMP); u16* T = (u16*)(ws + WS_T);
        const int row0 = u.pm * 256 + wr * 64 + fr, col0 = u.pn * 256 + wc * 32 + 4 * fq;
#pragma unroll
        for (int ai = 0; ai < 2; ++ai)
#pragma unroll
            for (int m = 0; m < 4; ++m) { const size_t r = row0 + ai * 128 + m * 16;
#pragma unroll
                for (int bj = 0; bj < 2; ++bj)
#pragma unroll
                    for (int n = 0; n < 2; ++n) { const int c = col0 + 128 * bj + 16 * n;
                        const u32x2 gb = *(const u32x2*)(G + r * G_P + c);
                        pg8::f32x4 gv; gv[0] = __uint_as_float(gb.x << 16); gv[1] = __uint_as_float(gb.x & 0xffff0000u); gv[2] = __uint_as_float(gb.y << 16); gv[3] = __uint_as_float(gb.y & 0xffff0000u);
                        pg8::f32x4 v = acc[ai][bj][m][n] * gv;
                        if (!SECOND) *(pg8::f32x4*)(TMP + r * DM + c) = v;
                        else { v += *(const pg8::f32x4*)(TMP + r * DM + c); u32x2 o; o.x = pk2(v[0], v[1]); o.y = pk2(v[2], v[3]); *(u32x2*)(T + r * DM + c) = o; } } }
    }
};

template <int FINAL> struct EpiRes {
    static constexpr bool PERM = false, AFTER_DRAIN = false;
    const Args* a;
    DI void operator()(AccRef acc, const pg8::Unit& u, int wr, int wc, int fr, int fq) const {
        asm volatile("" : "+v"(fr), "+v"(fq));
        const int pm = u.pm; const int grp = pm < 32 ? 0 : 1 + ((pm - 32) >> 2);
        const float* gate = (const float*)(a->ws + WS_CTL) + grp * 6144 + (FINAL ? 5120 : 2048);
        float* out = a->out + OUT_Y;
        const float* base = FINAL ? out : (pm < 32 ? a->in[I_XP] : a->in[I_XS] - (size_t)NCTX * DM);
        const int row0 = pm * 256 + wr * 64 + fr, col0 = u.pn * 256 + wc * 32 + 4 * fq;
        pg8::f32x4 gv[2][2];
#pragma unroll
        for (int bj = 0; bj < 2; ++bj)
#pragma unroll
            for (int n = 0; n < 2; ++n) gv[bj][n] = *(const pg8::f32x4*)(gate + col0 + 128 * bj + 16 * n);
#pragma unroll
        for (int ai = 0; ai < 2; ++ai)
#pragma unroll
            for (int m = 0; m < 4; ++m) { const size_t r = row0 + ai * 128 + m * 16;
#pragma unroll
                for (int bj = 0; bj < 2; ++bj)
#pragma unroll
                    for (int n = 0; n < 2; ++n) { const int c = col0 + 128 * bj + 16 * n;
                        const pg8::f32x4 b = *(const pg8::f32x4*)(base + r * DM + c);
                        *(pg8::f32x4*)(out + r * DM + c) = b + gv[bj][n] * acc[ai][bj][m][n]; } }
    }
};

struct EpiSwiglu {
    static constexpr bool PERM = false, AFTER_DRAIN = false;
    const Args* a;
    DI void operator()(AccRef acc, const pg8::Unit& u, int wr, int wc, int fr, int fq) const {
        asm volatile("" : "+v"(fr), "+v"(fq));
        u16* GU = (u16*)(a->ws + WS_GU);
        const int row0 = u.pm * 256 + wr * 64 + fr, col0 = u.pn * 128 + wc * 16 + 4 * fq;
#pragma unroll
        for (int ai = 0; ai < 2; ++ai)
#pragma unroll
            for (int m = 0; m < 4; ++m) { const size_t r = row0 + ai * 128 + m * 16;
#pragma unroll
                for (int bj = 0; bj < 2; ++bj) { const pg8::f32x4 g = acc[ai][bj][m][0], up = acc[ai][bj][m][1];
                    u32x2 o; o.x = pk2(siluf_(g[0]) * up[0], siluf_(g[1]) * up[1]); o.y = pk2(siluf_(g[2]) * up[2], siluf_(g[3]) * up[3]);
                    *(u32x2*)(GU + r * DFF + col0 + 64 * bj) = o; } }
    }
};
#define MFMA32(a, b, c) __builtin_amdgcn_mfma_f32_32x32x16_bf16((a), (b), (c), 0, 0, 0)
struct AState { float m, l; f32x16 o0, o1; };
struct AMask { int dq; int e0; const float* bp; };
DI int crow_(int i, int h) { return (i & 3) + 8 * (i >> 2) + 4 * h; }

template <int MODE>
DI void attn_tile(AState& st, const bf16x8 (&qf)[4], const u16* kp, const u16* vp, size_t v32, int h, const AMask& mk) {
    f32x16 s;
#pragma unroll
    for (int i = 0; i < 16; ++i) s[i] = 0.f;
    bf16x8 kf[4];
#pragma unroll
    for (int t = 0; t < 4; ++t) kf[t] = *(const bf16x8*)(kp + 16 * t);
    s16x4 va[2][2][2];
#pragma unroll
    for (int dt = 0; dt < 2; ++dt)
#pragma unroll
        for (int sI = 0; sI < 2; ++sI) { va[dt][sI][0] = *(const s16x4*)(vp + dt * v32 + 16 * sI); va[dt][sI][1] = *(const s16x4*)(vp + dt * v32 + 16 * sI + 8); }
#pragma unroll
    for (int t = 0; t < 4; ++t) s = MFMA32(kf[t], qf[t], s);
    float tmax = -1e30f;
#pragma unroll
    for (int i = 0; i < 16; ++i) {
        float v = s[i] * 0.125f; const int c = crow_(i, h);
        if (MODE == 1) { const int d = mk.dq - c; v = (d <= 128 && d >= -128) ? v : -INFINITY; }
        if (MODE == 2) { const bool ok = (unsigned)(mk.e0 + c) < 16u; const float b = ok ? mk.bp[c] : 0.f; v = ok ? v + b : -INFINITY; }
        s[i] = v; tmax = fmaxf(tmax, v);
    }
    tmax = fmaxf(tmax, __shfl_xor(tmax, 32));
    const float mnew = fmaxf(st.m, tmax), alpha = __expf(st.m - mnew);
    st.m = mnew;
    float psum = 0.f;
#pragma unroll
    for (int i = 0; i < 16; ++i) { const float p = __expf(s[i] - mnew); s[i] = p; psum += p; }
    st.l = st.l * alpha + psum;
#pragma unroll
    for (int i = 0; i < 16; ++i) { st.o0[i] *= alpha; st.o1[i] *= alpha; }
#pragma unroll
    for (int sI = 0; sI < 2; ++sI) {
        u32x4 pw; pw.x = pk2(s[8 * sI], s[8 * sI + 1]); pw.y = pk2(s[8 * sI + 2], s[8 * sI + 3]); pw.z = pk2(s[8 * sI + 4], s[8 * sI + 5]); pw.w = pk2(s[8 * sI + 6], s[8 * sI + 7]);
        const bf16x8 pb = __builtin_bit_cast(bf16x8, pw);
        const bf16x8 a0 = __builtin_shufflevector(va[0][sI][0], va[0][sI][1], 0, 1, 2, 3, 4, 5, 6, 7);
        const bf16x8 a1 = __builtin_shufflevector(va[1][sI][0], va[1][sI][1], 0, 1, 2, 3, 4, 5, 6, 7);
        st.o0 = MFMA32(a0, pb, st.o0);
        st.o1 = MFMA32(a1, pb, st.o1);
    }
}

constexpr int N_ITEMS_LB = 512, N_ITEMS_LA = 512, N_ITEMS_CTX = 4096, N_ITEMS = N_ITEMS_LB + N_ITEMS_LA + N_ITEMS_CTX;

DI void attn_phase(const Args& a) {
    const int lane = threadIdx.x & 63, r = lane & 31, h = lane >> 5;
    unsigned char* ws = a.ws;
    unsigned* queue = (unsigned*)(ws + WS_CTL + CTL_QUEUE);
    const u16* QKV = (const u16*)(ws + WS_QKV);
    for (;;) {
        unsigned it0 = 0;
        if (lane == 0) it0 = atomicAdd(queue, 1u);
        const int it = __builtin_amdgcn_readfirstlane(it0);
        if (it >= N_ITEMS) break;
        AState st;
#pragma unroll
        for (int i = 0; i < 16; ++i) { st.o0[i] = 0.f; st.o1[i] = 0.f; }
        st.m = -1e30f; st.l = 0.f;
        bf16x8 qf[4];
        u16* outp;
        AMask mk; mk.dq = 0; mk.e0 = 0; mk.bp = nullptr;
        if (it < N_ITEMS_LB) {
            const int b = it >> 8, hd = (it >> 5) & 7, qt = it & 31, rq = qt >> 1, c0q = (qt & 1) * 32;
            const size_t tok0 = (size_t)NCTX + b * 1024;
            const u16* qp = QKV + (tok0 + rq * 64 + c0q + r) * QKV_P + 768 + 64 * hd + 8 * h;
#pragma unroll
            for (int t = 0; t < 4; ++t) qf[t] = *(const bf16x8*)(qp + 16 * t);
            const int cq = c0q + r, cs = min(max(cq - 8, 0), 48), rs = min(max(rq - 4, 0), 8);
            const u16* vtb = (const u16*)(ws + WS_VTB_LAT) + ((size_t)(b * 8 + hd) * 64 + r) * 1024 + 4 * h;
            for (int kr = rs; kr < rs + 8; ++kr)
                for (int ct = 0; ct < 2; ++ct) {
                    const int key0 = kr * 64 + ct * 32, kc0 = ct * 32;
                    mk.e0 = kc0 - cs; mk.bp = a.in[I_RPB] + (hd * 15 + (kr - rq + 7)) * 31 + (kc0 - cq + 15);
                    attn_tile<2>(st, qf, QKV + (tok0 + key0 + r) * QKV_P + 1280 + 64 * hd + 8 * h, vtb + key0, (size_t)32 * 1024, h, mk);
                }
            const u16* ck = (const u16*)(ws + WS_CKB) + ((size_t)b * 256 + r) * 512 + 64 * hd + 8 * h;
            const u16* cv = (const u16*)(ws + WS_VCB) + ((size_t)(b * 8 + hd) * 64 + r) * 256 + 4 * h;
            for (int kt = 0; kt < 8; ++kt) attn_tile<0>(st, qf, ck + (size_t)kt * 32 * 512, cv + kt * 32, (size_t)32 * 256, h, mk);
            outp = (u16*)(ws + WS_YB) + (tok0 + rq * 64 + c0q + r) * 512 + 64 * hd;
        } else if (it < N_ITEMS_LB + N_ITEMS_LA) {
            const int i2 = it - N_ITEMS_LB, b = i2 >> 8, hd = (i2 >> 5) & 7, qt = i2 & 31, kvh = hd >> 2;
            const size_t tok0 = (size_t)NCTX + b * 1024;
            const u16* qp = QKV + (tok0 + qt * 32 + r) * QKV_P + 64 * hd + 8 * h;
#pragma unroll
            for (int t = 0; t < 4; ++t) qf[t] = *(const bf16x8*)(qp + 16 * t);
            st.m = a.in[I_SINK][hd]; st.l = h == 0 ? 1.f : 0.f;
            const u16* vtb = (const u16*)(ws + WS_VTA_LAT) + ((size_t)(b * 2 + kvh) * 64 + r) * 1024 + 4 * h;
            const int k_lo = max(qt - 4, 0), k_hi = min(qt + 4, 31);
            for (int kt = k_lo; kt <= k_hi; ++kt) {
                mk.dq = (qt - kt) * 32 + r;
                attn_tile<1>(st, qf, QKV + (tok0 + kt * 32 + r) * QKV_P + 512 + 64 * kvh + 8 * h, vtb + kt * 32, (size_t)32 * 1024, h, mk);
            }
            const u16* ck = (const u16*)(ws + WS_CKA) + ((size_t)b * 256 + r) * 128 + 64 * kvh + 8 * h;
            const u16* cv = (const u16*)(ws + WS_VCA) + ((size_t)(b * 2 + kvh) * 64 + r) * 256 + 4 * h;
            for (int kt = 0; kt < 8; ++kt) attn_tile<0>(st, qf, ck + (size_t)kt * 32 * 128, cv + kt * 32, (size_t)32 * 256, h, mk);
            outp = (u16*)(ws + WS_YA) + (tok0 + qt * 32 + r) * 512 + 64 * hd;
        } else {
            const int i3 = it - N_ITEMS_LB - N_ITEMS_LA, b = i3 >> 7, hh = (i3 >> 3) & 15, qt = i3 & 7;
            const size_t tok0 = (size_t)b * 256;
            const u16 *qp, *kp, *vp;
            if (hh < 8) { const int hd = hh, kvh = hd >> 2;
                qp = QKV + (tok0 + qt * 32 + r) * QKV_P + 64 * hd + 8 * h; kp = QKV + (tok0 + r) * QKV_P + 512 + 64 * kvh + 8 * h;
                vp = (const u16*)(ws + WS_VTA_CTX) + ((size_t)(b * 2 + kvh) * 64 + r) * 256 + 4 * h;
                st.m = a.in[I_SINK][hd]; st.l = h == 0 ? 1.f : 0.f;
                outp = (u16*)(ws + WS_YA) + (tok0 + qt * 32 + r) * 512 + 64 * hd;
            } else { const int hd = hh - 8;
                qp = QKV + (tok0 + qt * 32 + r) * QKV_P + 768 + 64 * hd + 8 * h; kp = QKV + (tok0 + r) * QKV_P + 1280 + 64 * hd + 8 * h;
                vp = (const u16*)(ws + WS_VTB_CTX) + ((size_t)(b * 8 + hd) * 64 + r) * 256 + 4 * h;
                outp = (u16*)(ws + WS_YB) + (tok0 + qt * 32 + r) * 512 + 64 * hd;
            }
#pragma unroll
            for (int t = 0; t < 4; ++t) qf[t] = *(const bf16x8*)(qp + 16 * t);
            for (int kt = 0; kt < 8; ++kt) attn_tile<0>(st, qf, kp + (size_t)kt * 32 * QKV_P, vp + kt * 32, (size_t)32 * 256, h, mk);
        }
        const float l = st.l + __shfl_xor(st.l, 32), inv = 1.f / l;
#pragma unroll
        for (int g = 0; g < 4; ++g) {
            u32x2 o; o.x = pk2(st.o0[4 * g] * inv, st.o0[4 * g + 1] * inv); o.y = pk2(st.o0[4 * g + 2] * inv, st.o0[4 * g + 3] * inv);
            *(u32x2*)(outp + 8 * g + 4 * h) = o;
            o.x = pk2(st.o1[4 * g] * inv, st.o1[4 * g + 1] * inv); o.y = pk2(st.o1[4 * g + 2] * inv, st.o1[4 * g + 3] * inv);
            *(u32x2*)(outp + 32 + 8 * g + 4 * h) = o;
        }
    }
}
constexpr int N_PHASES = 9;
__global__ void __launch_bounds__(512, 2) fwd_mega(Args args) {
    extern __shared__ __attribute__((aligned(16))) unsigned char lds_raw[];
    LAS unsigned char* lds = (LAS unsigned char*)lds_raw;
    cg::grid_group grid = cg::this_grid();
    const int lo = args.ph_lo, hi = args.ph_hi;
    unsigned char* ws = args.ws;
#ifndef PHASE_MASK
#define PHASE_MASK 0x1ff
#endif
#define IN(k) (((PHASE_MASK >> (k)) & 1) && lo <= (k) && (k) < hi)
#define SEAM(k) do { if (IN(k) && IN((k) + 1)) grid.sync(); } while (0)
    if (IN(0)) { p0_prologue(args, lds); }
    SEAM(0);
    if (IN(1)) { norm_mod_phase(args, 0); }
    SEAM(1);
    if (IN(2)) {
        pg8::Gemm g{(const pg8::bf16_t*)(ws + WS_H), (const pg8::bf16_t*)(ws + WS_WIN), MTOK, DIN, DM}; pg8::StaticOrder S; S.init(MTOK, DIN, gridDim.x, blockIdx.x);
        EpiIn E{&args};
        pg8::gemm_phase<EpiIn, pg8::StaticOrder, true, true>(lds, g, S, E);
    }
    SEAM(2);
    if (IN(3)) { attn_phase(args); }
    SEAM(3);
    if (IN(4)) {
        pg8::StaticOrder S; S.init(MTOK, DM, gridDim.x, blockIdx.x);
        { pg8::Gemm g{(const pg8::bf16_t*)(ws + WS_YA), (const pg8::bf16_t*)(ws + WS_WOA), MTOK, DM, 512}; EpiGate<0> E{&args};
          pg8::gemm_phase<EpiGate<0>, pg8::StaticOrder, true, true>(lds, g, S, E); }
        { pg8::Gemm g{(const pg8::bf16_t*)(ws + WS_YB), (const pg8::bf16_t*)(ws + WS_WOB), MTOK, DM, 512}; EpiGate<1> E{&args};
          pg8::gemm_phase<EpiGate<1>, pg8::StaticOrder, true, true>(lds, g, S, E); }
    }
    SEAM(4);
    if (IN(5)) {
        pg8::Gemm g{(const pg8::bf16_t*)(ws + WS_T), (const pg8::bf16_t*)(ws + WS_WO), MTOK, DM, DM}; pg8::StaticOrder S; S.init(MTOK, DM, gridDim.x, blockIdx.x);
        EpiRes<0> E{&args};
        pg8::gemm_phase<EpiRes<0>, pg8::StaticOrder, true, true>(lds, g, S, E);
    }
    SEAM(5);
    if (IN(6)) { norm_mod_phase(args, 1); }
    SEAM(6);
    if (IN(7)) {
        pg8::Gemm g{(const pg8::bf16_t*)(ws + WS_H), (const pg8::bf16_t*)(ws + WS_WGU), MTOK, NGU, DM}; pg8::StaticOrder S; S.init(MTOK, NGU, gridDim.x, blockIdx.x);
        EpiSwiglu E{&args};
        pg8::gemm_phase<EpiSwiglu, pg8::StaticOrder, true, true>(lds, g, S, E);
    }
    SEAM(7);
    if (IN(8)) {
        pg8::Gemm g{(const pg8::bf16_t*)(ws + WS_GU), (const pg8::bf16_t*)(ws + WS_WD), MTOK, DM, DFF}; pg8::StaticOrder S; S.init(MTOK, DM, gridDim.x, blockIdx.x);
        EpiRes<1> E{&args};
        pg8::gemm_phase<EpiRes<1>, pg8::StaticOrder, true, true>(lds, g, S, E);
    }
#undef IN
#undef SEAM
}

#ifndef N_LAUNCH_MODE
#define N_LAUNCH_MODE 1
#endif
extern "C" void kernel_launch(void* const* d_in, const int* in_sizes, int n_in, void* d_out, int out_size, void* d_ws, size_t ws_size, hipStream_t stream) {
    static int grid = 0;
    if (grid == 0) {
        int dev = 0, cus = 0, per_cu = 0;
        (void)hipGetDevice(&dev);
        (void)hipDeviceGetAttribute(&cus, hipDeviceAttributeMultiprocessorCount, dev);
        (void)hipFuncSetAttribute((const void*)fwd_mega, hipFuncAttributeMaxDynamicSharedMemorySize, LDS_BYTES);
        (void)hipOccupancyMaxActiveBlocksPerMultiprocessor(&per_cu, (const void*)fwd_mega, 512, LDS_BYTES);
        if (per_cu < 1) { fprintf(stderr, "occupancy query says %d blocks/CU\n", per_cu); per_cu = 1; }
        grid = cus * per_cu;
        if (n_in != 25) fprintf(stderr, "kernel_launch: expected 25 inputs, got %d\n", n_in);
    }
    (void)hipMemsetAsync((char*)d_ws + WS_CTL, 0, CTL_BYTES, stream);
    Args a{};
    for (int i = 0; i < 25; ++i) a.in[i] = (const float*)d_in[i];
    a.out = (float*)d_out; a.ws = (unsigned char*)d_ws;
    if (N_LAUNCH_MODE == 1) {
        a.ph_lo = 0; a.ph_hi = N_PHASES;
        void* kargs[] = {&a};
        hipError_t e = hipLaunchCooperativeKernel((const void*)fwd_mega, dim3(grid), dim3(512), kargs, LDS_BYTES, stream);
        if (e != hipSuccess) fprintf(stderr, "cooperative launch failed: %s (grid %d)\n", hipGetErrorString(e), grid);
    } else {
        for (int p = 0; p < N_PHASES; ++p) { a.ph_lo = p; a.ph_hi = p + 1; hipLaunchKernelGGL(fwd_mega, dim3(grid), dim3(512), LDS_BYTES, stream, a); }
    }
}
```

```cpp
#include <hip/hip_runtime.h>
#include <hip/hip_cooperative_groups.h>
#include <cstdio>
#include <cstdint>
namespace cg = cooperative_groups;
namespace pg8 {
#define PG8_LAS __attribute__((address_space(3)))
typedef unsigned short bf16_t;
typedef short bf16x8 __attribute__((ext_vector_type(8)));
typedef float f32x4 __attribute__((ext_vector_type(4)));
typedef unsigned u32x4 __attribute__((ext_vector_type(4)));
constexpr int BM = 256, BK = 64, HALF = 128, HTB = HALF * BK * 2  , STAGE_BYTES = 8 * HTB, NXCD = 8, WGM = 8;

__host__ __device__ __forceinline__ int lds_byte(int r, int c) { const int st = (r >> 4) * 2 + (c >> 5), rr = r & 15, cc = c & 31, ob = rr * 64 + cc * 2; return st * 1024 + (ob ^ (((ob >> 9) & 1) << 5)); }
__host__ __device__ __forceinline__ void stage_rc(int b, int& R, int& C) { const int st = b / 1024, sb = b % 1024, swz = sb ^ (((sb >> 9) & 1) << 5); R = (st >> 1) * 16 + swz / 64; C = (st & 1) * 32 + (swz % 64) / 2; }
__host__ __device__ __forceinline__ int perm32(int rho) { const int n = rho >> 4, i = rho & 15; return 8 * (i >> 2) + 4 * n + (i & 3); }

struct Unit { int pm, pn; };
struct Gemm { const bf16_t* A; const bf16_t* Bt; int M, N, K; };

struct StaticOrder {
    int nM, nN, nwg, G, c, reps;
    __host__ __device__ void init(int M, int N, int G_, int c_, int reps_ = 1) { nM = M / BM; nN = N / BM; nwg = nM * nN; G = G_; c = c_; reps = reps_; }
    __host__ __device__ bool next(int i, Unit& u) const {
        const long L = (long)i * G + c; if (L >= (long)nwg * reps) return false;
        int wgid = (int)(L % nwg); { const int q = nwg / NXCD, r = nwg % NXCD, xcd = wgid % NXCD, off = wgid / NXCD; wgid = (xcd < r ? xcd * (q + 1) : r * (q + 1) + (xcd - r) * q) + off; }
        const int nig = WGM * nN, gid = wgid / nig, fm = gid * WGM, gsz = (nM - fm) < WGM ? (nM - fm) : WGM;
        u.pm = fm + ((wgid % nig) % gsz); u.pn = (wgid % nig) / gsz; return true;
    }
    __device__ __forceinline__ void a_ready(const Unit&) const {}
    __device__ __forceinline__ void done(const Unit&) const {}
};

__device__ __forceinline__ unsigned cvt_pk_bf16(float lo, float hi) { unsigned r; asm volatile("v_cvt_pk_bf16_f32 %0, %1, %2" : "=v"(r) : "v"(lo), "v"(hi)); return r; }

template <class Epi, class Sched, bool ALIGN_EPI = false, bool SP2 = false>
__device__ __forceinline__ void gemm_phase(PG8_LAS unsigned char* lds, const Gemm g, const Sched& S, const Epi& E) {
    const int tid = threadIdx.x, wid = __builtin_amdgcn_readfirstlane(tid >> 6), lane = tid & 63, wr = wid >> 2, wc = wid & 3, fr = lane & 15, fq = lane >> 4;
    const int K = g.K, nt = K / BK;
    unsigned voffA[2], voffB[2];
#pragma unroll
    for (int i = 0; i < 2; ++i) { int R, C; stage_rc(tid * 16 + i * 8192, R, C); const int Rb = Epi::PERM ? ((R & ~31) + perm32(R & 31)) : R;
        voffA[i] = (unsigned)(R * K + C) * 2u; voffB[i] = (unsigned)(Rb * K + C) * 2u; }
    const size_t kstep = (size_t)(BK * 2);
    const size_t hstep = (size_t)HALF * K * 2;
    const size_t tstep = 2 * hstep;
    const unsigned ldsw = (unsigned)wid * 1024u;
    const int aoff = lds_byte(wr * 64 + fr, fq * 8), boff = lds_byte(wc * 32 + fr, fq * 8);
#define PG8_SA(b, h) (((b) * 2 + (h)) * HTB)
#define PG8_SB(b, h) ((4 + (b) * 2 + (h)) * HTB)
#define PG8_STAGE(bufoff, gbase, voff) do { _Pragma("unroll") for (int _i = 0; _i < 2; ++_i) \
        __builtin_amdgcn_global_load_lds((const unsigned*)((const char*)(gbase) + (voff)[_i]), (PG8_LAS unsigned*)(lds + (bufoff) + ldsw + _i * 8192), 16, 0, 0); } while (0)
#define PG8_LDA(dst, b, h) do { _Pragma("unroll") for (int m = 0; m < 4; ++m) _Pragma("unroll") for (int k = 0; k < 2; ++k) dst[m][k] = *(const PG8_LAS bf16x8*)(lds + PG8_SA(b, h) + aoff + m * 2048 + k * 1024); } while (0)
#define PG8_LDB(dst, b, h) do { _Pragma("unroll") for (int n = 0; n < 2; ++n) _Pragma("unroll") for (int k = 0; k < 2; ++k) dst[n][k] = *(const PG8_LAS bf16x8*)(lds + PG8_SB(b, h) + boff + n * 2048 + k * 1024); } while (0)
#define PG8_MMA(ai, bj, At, Bt) do { __builtin_amdgcn_s_setprio(1); _Pragma("unroll") for (int m = 0; m < 4; ++m) _Pragma("unroll") for (int n = 0; n < 2; ++n) _Pragma("unroll") for (int k = 0; k < 2; ++k) \
        acc[ai][bj][m][n] = __builtin_amdgcn_mfma_f32_16x16x32_bf16(Bt[n][k], At[m][k], acc[ai][bj][m][n], 0, 0, 0); __builtin_amdgcn_s_setprio(0); } while (0)
#define PG8_WAIT_V(n) asm volatile("s_waitcnt vmcnt(" #n ")" ::: "memory")
#define PG8_WAIT_L(n) asm volatile("s_waitcnt lgkmcnt(" #n ")" ::: "memory")
#define PG8_BAR __builtin_amdgcn_s_barrier()
#define PG8_SCHED __builtin_amdgcn_sched_barrier(0)
    Unit cur, nxt; int ui = 0;
    if (!S.next(0, cur)) return;
    f32x4 acc[2][2][4][2];
#pragma unroll
    for (int a = 0; a < 2; ++a)
#pragma unroll
        for (int b = 0; b < 2; ++b)
#pragma unroll
            for (int m = 0; m < 4; ++m)
#pragma unroll
                for (int n = 0; n < 2; ++n) acc[a][b][m][n] = (f32x4){0.f, 0.f, 0.f, 0.f};
    bf16x8 At[4][2], B0[2][2], B1[2][2];
    const char* cA = (const char*)g.A + (size_t)cur.pm * tstep; const char* cB = (const char*)g.Bt + (size_t)cur.pn * tstep;
    S.a_ready(cur);
    if constexpr (SP2) {
        PG8_STAGE(PG8_SB(0, 0), cB, voffB); PG8_STAGE(PG8_SB(0, 1), cB + hstep, voffB); PG8_STAGE(PG8_SA(0, 0), cA, voffA); PG8_STAGE(PG8_SA(0, 1), cA + hstep, voffA);
        if (wr == 1) PG8_BAR;
        PG8_WAIT_V(2); PG8_BAR;
        PG8_STAGE(PG8_SB(1, 0), cB + kstep, voffB); PG8_STAGE(PG8_SA(1, 0), cA + kstep, voffA); PG8_STAGE(PG8_SB(1, 1), cB + hstep + kstep, voffB);
        PG8_WAIT_V(6); PG8_BAR;
    } else {
        PG8_STAGE(PG8_SB(0, 0), cB, voffB); PG8_STAGE(PG8_SA(0, 0), cA, voffA); PG8_STAGE(PG8_SB(0, 1), cB + hstep, voffB); PG8_STAGE(PG8_SA(0, 1), cA + hstep, voffA);
        if (wr == 1) PG8_BAR;
        PG8_WAIT_V(4); PG8_BAR;
        PG8_STAGE(PG8_SB(1, 0), cB + kstep, voffB); PG8_STAGE(PG8_SA(1, 0), cA + kstep, voffA); PG8_STAGE(PG8_SB(1, 1), cB + hstep + kstep, voffB);
        PG8_WAIT_V(6); PG8_BAR;
    }
    for (;;) {
        const bool has_next = S.next(ui + 1, nxt);
        const char* nA = has_next ? (const char*)g.A + (size_t)nxt.pm * tstep : cA; const char* nB = has_next ? (const char*)g.Bt + (size_t)nxt.pn * tstep : cB;
        for (int t = 0; t < nt; t += 2) {
            const bool last = (t == nt - 2);
            const char* a1 = cA + (size_t)(t + 1) * kstep;
            const char* a2 = last ? nA : cA + (size_t)(t + 2) * kstep; const char* b2 = last ? nB : cB + (size_t)(t + 2) * kstep;
            const char* a3 = a2 + kstep; const char* b3 = b2 + kstep;
            if (last && has_next) S.a_ready(nxt);
            if constexpr (SP2) {
            PG8_LDB(B0, 0, 0); PG8_LDB(B1, 0, 1); PG8_SCHED; PG8_LDA(At, 0, 0); PG8_STAGE(PG8_SA(1, 1), a1 + hstep, voffA);
            PG8_WAIT_V(8); PG8_WAIT_L(0); PG8_BAR; PG8_MMA(0, 0, At, B0); PG8_MMA(0, 1, At, B1); PG8_BAR; PG8_SCHED;
            PG8_LDA(At, 0, 1); PG8_STAGE(PG8_SB(0, 0), b2, voffB); PG8_STAGE(PG8_SB(0, 1), b2 + hstep, voffB); PG8_STAGE(PG8_SA(0, 0), a2, voffA);
            PG8_WAIT_V(8); PG8_WAIT_L(0); PG8_BAR; PG8_MMA(1, 0, At, B0); PG8_MMA(1, 1, At, B1); PG8_BAR; PG8_SCHED;
            PG8_LDB(B0, 1, 0); PG8_LDB(B1, 1, 1); PG8_SCHED; PG8_LDA(At, 1, 0); PG8_STAGE(PG8_SA(0, 1), a2 + hstep, voffA);
            PG8_WAIT_V(8); PG8_WAIT_L(0); PG8_BAR; PG8_MMA(0, 0, At, B0); PG8_MMA(0, 1, At, B1); PG8_BAR; PG8_SCHED;
            PG8_LDA(At, 1, 1); PG8_STAGE(PG8_SB(1, 0), b3, voffB); PG8_STAGE(PG8_SB(1, 1), b3 + hstep, voffB); PG8_STAGE(PG8_SA(1, 0), a3, voffA);
            PG8_WAIT_V(8); PG8_WAIT_L(0); PG8_BAR; PG8_MMA(1, 0, At, B0); PG8_MMA(1, 1, At, B1); PG8_BAR; PG8_SCHED;
            } else {
            PG8_LDB(B0, 0, 0); PG8_SCHED; PG8_LDA(At, 0, 0); PG8_STAGE(PG8_SA(1, 1), a1 + hstep, voffA);
            PG8_WAIT_L(8); PG8_BAR; PG8_WAIT_L(0); PG8_MMA(0, 0, At, B0); PG8_BAR; PG8_SCHED;
            PG8_LDB(B1, 0, 1); PG8_STAGE(PG8_SB(0, 0), b2, voffB);
            PG8_BAR; PG8_WAIT_L(0); PG8_MMA(0, 1, At, B1); PG8_BAR;
            PG8_LDA(At, 0, 1); PG8_STAGE(PG8_SA(0, 0), a2, voffA);
            PG8_BAR; PG8_WAIT_L(0); PG8_MMA(1, 0, At, B0); PG8_BAR; PG8_SCHED;
            PG8_STAGE(PG8_SB(0, 1), b2 + hstep, voffB);
            PG8_WAIT_V(6); PG8_BAR; PG8_MMA(1, 1, At, B1); PG8_BAR;
            PG8_LDB(B0, 1, 0); PG8_SCHED; PG8_LDA(At, 1, 0); PG8_STAGE(PG8_SA(0, 1), a2 + hstep, voffA);
            PG8_WAIT_L(8); PG8_BAR; PG8_WAIT_L(0); PG8_MMA(0, 0, At, B0); PG8_BAR; PG8_SCHED;
            PG8_LDB(B1, 1, 1); PG8_STAGE(PG8_SB(1, 0), b3, voffB);
            PG8_BAR; PG8_WAIT_L(0); PG8_MMA(0, 1, At, B1); PG8_BAR;
            PG8_LDA(At, 1, 1); PG8_STAGE(PG8_SA(1, 0), a3, voffA);
            PG8_BAR; PG8_WAIT_L(0); PG8_MMA(1, 0, At, B0); PG8_BAR; PG8_SCHED;
            PG8_STAGE(PG8_SB(1, 1), b3 + hstep, voffB);
            PG8_WAIT_V(6); PG8_BAR; PG8_MMA(1, 1, At, B1); PG8_BAR;
            }
        }
        if constexpr (ALIGN_EPI) { if (wr == 0) PG8_BAR; }
        if constexpr (!Epi::AFTER_DRAIN) { E(acc, cur, wr, wc, fr, fq); S.done(cur); }
        if (!has_next) break;
#pragma unroll
        for (int a = 0; a < 2; ++a)
#pragma unroll
            for (int b = 0; b < 2; ++b)
#pragma unroll
                for (int m = 0; m < 4; ++m)
#pragma unroll
                    for (int n = 0; n < 2; ++n) acc[a][b][m][n] = (f32x4){0.f, 0.f, 0.f, 0.f};
        cur = nxt; cA = nA; cB = nB; ++ui;
        if constexpr (ALIGN_EPI) { if (wr == 1) PG8_BAR; }
    }
    PG8_WAIT_V(0);
    if constexpr (!ALIGN_EPI) { if (wr == 0) PG8_BAR; }
    PG8_BAR;
    if constexpr (Epi::AFTER_DRAIN) { E.fused(acc, cur, wr, wc, fr, fq, lds, wid, lane); S.done(cur); }
#undef PG8_SA
#undef PG8_SB
#undef PG8_STAGE
#undef PG8_LDA
#undef PG8_LDB
#undef PG8_MMA
#undef PG8_WAIT_V
#undef PG8_WAIT_L
#undef PG8_BAR
#undef PG8_SCHED
}
}

#define DI __device__ __forceinline__
#define LAS __attribute__((address_space(3)))
typedef unsigned short u16;
typedef float f32x4 __attribute__((ext_vector_type(4)));
typedef float f32x16 __attribute__((ext_vector_type(16)));
typedef float f32x2 __attribute__((ext_vector_type(2)));
typedef short bf16x8 __attribute__((ext_vector_type(8)));
typedef short s16x4 __attribute__((ext_vector_type(4)));
typedef unsigned u32x2 __attribute__((ext_vector_type(2)));
typedef unsigned u32x4 __attribute__((ext_vector_type(4)));
typedef __bf16 bf16x2_t __attribute__((ext_vector_type(2)));

constexpr int DM = 1024, NCTX = 8192, NLAT = 2048, MTOK = 10240, DIN = 4352, DFF = 2816, NGU = 2 * DFF;
constexpr int QKV_P = 2304, G_P = 2048;
constexpr size_t MiB = 1u << 20;
constexpr size_t WS_CTL = 0, CTL_BYTES = 128 * 1024, CTL_QUEUE = 81920;
constexpr size_t CTL_BAR = 90112;
constexpr size_t WS_ROPE = 512 * 1024;
constexpr size_t WS_WIN = 1 * MiB, WS_WOA = 10 * MiB, WS_WOB = 11 * MiB, WS_WO = 12 * MiB, WS_WGU = 14 * MiB, WS_WD = 25 * MiB;
constexpr size_t WS_CKA = 31 * MiB, WS_CKB = 31 * MiB + 128 * 1024, WS_VCA = 32 * MiB, WS_VCB = 32 * MiB + 128 * 1024;
constexpr size_t WS_VTA_CTX = 33 * MiB, WS_VTB_CTX = 35 * MiB, WS_VTA_LAT = 43 * MiB, WS_VTB_LAT = 44 * MiB;
constexpr size_t WS_H = 46 * MiB, WS_QKV = 66 * MiB, WS_G = 111 * MiB, WS_YA = 151 * MiB, WS_YB = 161 * MiB, WS_TMP = 171 * MiB, WS_T = 211 * MiB, WS_GU = 66 * MiB;
constexpr size_t OUT_Y = 0, OUT_AK = 10485760, OUT_AV = 11534336, OUT_BK = 12582912, OUT_BV = 16777216;
constexpr int LDS_BYTES = 147456, LDS_XB = 147456 - 64;
constexpr float RMS_EPS = 1e-6f;

DI unsigned pk2(float lo, float hi) { f32x2 v = {lo, hi}; bf16x2_t b = __builtin_convertvector(v, bf16x2_t); return __builtin_bit_cast(unsigned, b); }
DI u16 bf1(float x) { return (u16)(pk2(x, 0.f) & 0xffffu); }
DI float wave_sum(float v) {
#pragma unroll
    for (int o = 1; o < 64; o <<= 1) v += __shfl_xor(v, o);
    return v;
}
DI float sigmoidf_(float x) { return 1.0f / (1.0f + __expf(-x)); }
DI float siluf_(float x) { return x / (1.0f + __expf(-x)); }

struct Args { const float* in[25]; float* out; unsigned char* ws; int ph_lo, ph_hi; };
enum { I_XP = 0, I_XS, I_CAK, I_CAV, I_CBK, I_CBV, I_C, I_CCTX, I_WADA, I_BADA, I_GATTN, I_WIN, I_QNA, I_KNA, I_QNB, I_KNB, I_SINK, I_RPB, I_WOA, I_WOB, I_WO, I_GFFN, I_WG, I_WU, I_WD };

DI int dest_row(int mode, int n) {
    if (mode == 0) return n;
    if (mode == 1) { const int pn = n >> 8, wc = (n >> 6) & 3, bj = (n >> 5) & 1, e = n & 31; return (pn << 8) + (bj << 7) + (wc << 5) + e; }
    const int pn = n >> 7, rem = n & 127, bj = rem >> 6, wc = (rem >> 4) & 3, e = rem & 15;
    return (pn << 8) + (bj << 7) + (wc << 5) + ((mode == 3) ? 16 : 0) + e;
}
DI void p0_transpose_item(const float* W, int K, int N, u16* WT, int mode, LAS float* scr, int item, int lane) {
    const int nblk = N / 32, kb = item / nblk, nb = item % nblk, k0 = 64 * kb, n0 = 32 * nb;
#pragma unroll 8
    for (int i = 0; i < 32; ++i) { const int kk = 2 * i + (lane >> 5); scr[kk * 33 + (lane & 31)] = W[(size_t)(k0 + kk) * N + n0 + (lane & 31)]; }
    asm volatile("s_waitcnt lgkmcnt(0)" ::: "memory");
    const int c = lane & 7;
#pragma unroll
    for (int j = 0; j < 4; ++j) { const int n = (lane >> 3) + 8 * j; const LAS float* s = scr + (8 * c) * 33 + n;
        u32x4 o; o.x = pk2(s[0 * 33], s[1 * 33]); o.y = pk2(s[2 * 33], s[3 * 33]); o.z = pk2(s[4 * 33], s[5 * 33]); o.w = pk2(s[6 * 33], s[7 * 33]);
        *(u32x4*)(WT + (size_t)dest_row(mode, n0 + n) * K + k0 + 8 * c) = o; }
    asm volatile("s_waitcnt lgkmcnt(0)" ::: "memory");
}

DI void p0_prologue(const Args& a, LAS unsigned char* lds, bool do_ada) {
    (void)do_ada;
    const int tid = threadIdx.x, lane = tid & 63, wave = __builtin_amdgcn_readfirstlane(tid >> 6);
    const int gw = blockIdx.x * 8 + wave, NGW = gridDim.x * 8;
    unsigned char* ws = a.ws;
    LAS float* scr = (LAS float*)(lds + wave * 16384);
    float* ada = (float*)(ws + WS_CTL);
    {
        LAS float* red = (LAS float*)(lds + 8 * 16384);
        const int cl = lane & 31, rp = wave * 2 + (lane >> 5);
        for (int cb = blockIdx.x; cb < 6144 / 32; cb += gridDim.x) {
            const float* wp = a.in[I_WADA] + (size_t)rp * 6144 + cb * 32 + cl;
            float a0 = 0.f, a1 = 0.f, a2 = 0.f;
#pragma unroll 16
            for (int k = 0; k < 64; ++k) {
                const int kk = rp + 16 * k;
                const float w = wp[(size_t)k * 16 * 6144];
                const float s0 = siluf_(a.in[I_CCTX][kk]), s1 = siluf_(a.in[I_C][kk]), s2 = siluf_(a.in[I_C][1024 + kk]);
                a0 += w * s0; a1 += w * s1; a2 += w * s2;
            }
            red[(rp * 3 + 0) * 32 + cl] = a0; red[(rp * 3 + 1) * 32 + cl] = a1; red[(rp * 3 + 2) * 32 + cl] = a2;
            __syncthreads();
            if (tid < 96) { const int v = tid >> 5, c = tid & 31; float t = a.in[I_BADA][cb * 32 + c];
#pragma unroll
                for (int q = 0; q < 16; ++q) t += red[(q * 3 + v) * 32 + c];
                ada[v * 6144 + cb * 32 + c] = t; }
            __syncthreads();
        }
    }
    constexpr int I_IN = 16 * (DIN / 32), I_OA = 8 * 32, I_OB = 8 * 32, I_O = 16 * 32, I_G = 16 * (DFF / 32), I_U = I_G, I_D = (DFF / 64) * 32;
    constexpr int NITEMS = I_IN + I_OA + I_OB + I_O + I_G + I_U + I_D;
    for (int it = gw; it < NITEMS; it += NGW) {
        int r = it;
        if (r < I_IN) { p0_transpose_item(a.in[I_WIN], DM, DIN, (u16*)(ws + WS_WIN), 1, scr, r, lane); continue; } r -= I_IN;
        if (r < I_OA) { p0_transpose_item(a.in[I_WOA], 512, DM, (u16*)(ws + WS_WOA), 0, scr, r, lane); continue; } r -= I_OA;
        if (r < I_OB) { p0_transpose_item(a.in[I_WOB], 512, DM, (u16*)(ws + WS_WOB), 0, scr, r, lane); continue; } r -= I_OB;
        if (r < I_O) { p0_transpose_item(a.in[I_WO], DM, DM, (u16*)(ws + WS_WO), 0, scr, r, lane); continue; } r -= I_O;
        if (r < I_G) { p0_transpose_item(a.in[I_WG], DM, DFF, (u16*)(ws + WS_WGU), 2, scr, r, lane); continue; } r -= I_G;
        if (r < I_U) { p0_transpose_item(a.in[I_WU], DM, DFF, (u16*)(ws + WS_WGU), 3, scr, r, lane); continue; } r -= I_U;
        p0_transpose_item(a.in[I_WD], DFF, DM, (u16*)(ws + WS_WD), 0, scr, r, lane);
    }
    if (blockIdx.x == 0) { for (int i = tid; i < 64 * 16; i += 512) { const int pos = i >> 4, fi = i & 15; const float ang = (float)pos * exp2f(-(float)fi * (13.287712379549449f / 16.0f));
        float* rt = (float*)(ws + WS_ROPE) + (pos * 4 + (fi >> 2)) * 8 + (fi & 3); rt[0] = cosf(ang); rt[4] = sinf(ang); } }
    const int gt = blockIdx.x * 512 + tid, NGT = gridDim.x * 512;
    for (int i = gt; i < 2 * 256 * 128; i += NGT) {
        ((u16*)(ws + WS_CKA))[i] = bf1(a.in[I_CAK][i]);
        const int d = i & 63, hd = (i >> 6) & 1, key = (i >> 7) & 255, b = i >> 15;
        ((u16*)(ws + WS_VCA))[((b * 2 + hd) * 64 + d) * 256 + key] = bf1(a.in[I_CAV][i]);
    }
    for (int i = gt; i < 2 * 256 * 512; i += NGT) {
        ((u16*)(ws + WS_CKB))[i] = bf1(a.in[I_CBK][i]);
        const int d = i & 63, hd = (i >> 6) & 7, key = (i >> 9) & 255, b = i >> 17;
        ((u16*)(ws + WS_VCB))[((b * 8 + hd) * 64 + d) * 256 + key] = bf1(a.in[I_CBV][i]);
    }
}

DI void norm_mod_phase(const Args& a, int which) {
    const int tid = threadIdx.x, lane = tid & 63, wave = tid >> 6;
    const int gw = blockIdx.x * 8 + wave, NGW = gridDim.x * 8;
    const float* ada = (const float*)(a.ws + WS_CTL);
    const float* g = a.in[which ? I_GFFN : I_GATTN];
    u16* H = (u16*)(a.ws + WS_H);
    for (int r = gw; r < MTOK; r += NGW) {
        const float* xrow = which ? ((const float*)(a.ws + WS_TMP) + (size_t)r * DM) : (r < NCTX ? a.in[I_XP] + (size_t)r * DM : a.in[I_XS] + (size_t)(r - NCTX) * DM);
        const int grp = r < NCTX ? 0 : 1 + ((r - NCTX) >> 10);
        const float* sh = ada + grp * 6144 + (which ? 3072 : 0);
        const float* sc = sh + 1024;
        f32x4 v[4]; float ss = 0.f;
#pragma unroll
        for (int j = 0; j < 4; ++j) { v[j] = *(const f32x4*)(xrow + 4 * lane + 256 * j); ss += (v[j].x * v[j].x + v[j].y * v[j].y) + (v[j].z * v[j].z + v[j].w * v[j].w); }
        const float rstd = rsqrtf(wave_sum(ss) * (1.f / DM) + RMS_EPS);
#pragma unroll
        for (int j = 0; j < 4; ++j) {
            const int c = 4 * lane + 256 * j;
            const f32x4 gg = *(const f32x4*)(g + c), s1 = *(const f32x4*)(sc + c), s0 = *(const f32x4*)(sh + c);
            const f32x4 y = (v[j] * rstd * gg) * (s1 + 1.0f) + s0;
            u32x2 o; o.x = pk2(y.x, y.y); o.y = pk2(y.z, y.w);
            *(u32x2*)(H + (size_t)r * DM + c) = o;
        }
    }
}
#define XB_TMO      128
#define XB_XCNT(j)  (256  + 64 * (j))
#define XB_XSUB(j)  (1280 + 64 * (j))
#define XB_XGEN(j)  (2304 + 64 * (j))
#define XB_TOP      3328
#define XB_TOPGEN   3392
#define XCD_BAR_WORDS 3456
#define XB_SPIN_CAP (1u << 18)

__device__ __forceinline__ unsigned xb_ld(unsigned* p)              { return __hip_atomic_load(p, __ATOMIC_RELAXED, __HIP_MEMORY_SCOPE_AGENT); }
__device__ __forceinline__ unsigned xb_add(unsigned* p, unsigned v) { return __hip_atomic_fetch_add(p, v, __ATOMIC_RELAXED, __HIP_MEMORY_SCOPE_AGENT); }
__device__ __forceinline__ unsigned xb_xcc_id() { return (unsigned)__builtin_amdgcn_s_getreg((3 << 11) | 20) & 0xFu; }
#define XB_SPIN(cond, bar) do { unsigned _sp = 0; while (cond) { __builtin_amdgcn_s_sleep(1); \
    if ((++_sp & 255u) == 0u) { if (xb_ld(&(bar)[XB_TMO])) break; if (_sp > XB_SPIN_CAP) { atomicAdd(&(bar)[XB_TMO], 1u); break; } } } } while (0)

struct XcdBarrier {
    unsigned* bar; unsigned x;
    volatile LAS unsigned* st;
};

__device__ __forceinline__ XcdBarrier xcd_barrier_post(unsigned* bar, volatile LAS unsigned* st) {
    XcdBarrier b; b.bar = bar; b.x = xb_xcc_id(); b.st = st;
    if (threadIdx.x == 0) (void)xb_add(&bar[XB_XCNT(b.x)], 1u);
    return b;
}
__device__ __forceinline__ void xcd_barrier_complete(unsigned* bar, unsigned x, unsigned& nloc, unsigned& nx) {
    const unsigned G = gridDim.x * gridDim.y * gridDim.z;
    unsigned sum, cnt, mine, sp = 0u;
    for (;;) {
        sum = 0u; cnt = 0u; mine = 0u;
#pragma unroll
        for (unsigned j = 0; j < 16; ++j) { const unsigned c = xb_ld(&bar[XB_XCNT(j)]); sum += c; cnt += (c > 0u) ? 1u : 0u; mine = (j == x) ? c : mine; }
        if (sum == G) break;
        __builtin_amdgcn_s_sleep(1);
        if ((++sp & 255u) == 0u) { if (xb_ld(&bar[XB_TMO])) break; if (sp > XB_SPIN_CAP) { atomicAdd(&bar[XB_TMO], 1u); break; } }
    }
    nloc = mine > 0u ? mine : 1u; nx = cnt > 0u ? cnt : 1u;
}

__device__ __forceinline__ void xcd_barrier(const XcdBarrier& b) {
    asm volatile("s_waitcnt vmcnt(0)" ::: "memory");
    __syncthreads();
    if (threadIdx.x == 0) {
        unsigned* bar = b.bar;
        __builtin_amdgcn_s_waitcnt(0);
        unsigned nloc = b.st[0], nx = b.st[1];
        if (nloc == 0u) { xcd_barrier_complete(bar, b.x, nloc, nx); b.st[0] = nloc; b.st[1] = nx; }
        const unsigned old = xb_add(&bar[XB_XSUB(b.x)], 1u);
        const unsigned gen = old / nloc;
        if (old + 1u == (gen + 1u) * nloc) {
            __builtin_amdgcn_fence(__ATOMIC_RELEASE, "agent");
            asm volatile("s_waitcnt vmcnt(0)" ::: "memory");
            const unsigned og = xb_add(&bar[XB_TOP], 1u);
            const unsigned tg = og / nx;
            if (og + 1u == (tg + 1u) * nx) xb_add(&bar[XB_TOPGEN], 1u);
            else XB_SPIN(xb_ld(&bar[XB_TOPGEN]) == tg, bar);
            __builtin_amdgcn_fence(__ATOMIC_ACQUIRE, "agent");
            xb_add(&bar[XB_XGEN(b.x)], 1u);
            asm volatile("s_waitcnt vmcnt(0)" ::: "memory");
        } else {
            XB_SPIN(xb_ld(&bar[XB_XGEN(b.x)]) == gen, bar);
            __builtin_amdgcn_fence(__ATOMIC_ACQUIRE, "agent");
            asm volatile("s_waitcnt vmcnt(0)" ::: "memory");
        }
    }
    __syncthreads();
}

typedef const pg8::f32x4 (&AccRef)[2][2][4][2];

struct EpiIn {
    static constexpr bool PERM = false, AFTER_DRAIN = false;
    const Args* a;
    DI void operator()(AccRef acc, const pg8::Unit& u, int wr, int wc, int fr, int fq) const {
        asm volatile("" : "+v"(fr), "+v"(fq));
        unsigned char* ws = a->ws;
        const int pn = u.pn, pm = u.pm;
        const bool lat = pm >= 32;
        const int row0 = pm * 256 + wr * 64 + fr;
        if (pn >= 9) {
            u16* G = (u16*)(ws + WS_G);
#pragma unroll
            for (int ai = 0; ai < 2; ++ai)
#pragma unroll
                for (int m = 0; m < 4; ++m) { u16* rp = G + (size_t)(row0 + ai * 128 + m * 16) * G_P + (pn - 9) * 256 + wc * 64 + 4 * fq;
#pragma unroll
                    for (int bj = 0; bj < 2; ++bj)
#pragma unroll
                        for (int n = 0; n < 2; ++n) { const pg8::f32x4 v = acc[ai][bj][m][n]; u32x2 o; o.x = pk2(sigmoidf_(v[0]), sigmoidf_(v[1])); o.y = pk2(sigmoidf_(v[2]), sigmoidf_(v[3]));
                            *(u32x2*)(rp + 32 * bj + 16 * n) = o; } }
            return;
        }
        const bool isv = (pn == 2 && wc >= 2) || pn == 7 || pn == 8;
        if (isv) {
            int nh, hd; u16* vt; float* ov;
            if (pn == 2) { nh = 2; hd = wc - 2; vt = (u16*)(ws + (lat ? WS_VTA_LAT : WS_VTA_CTX)); ov = a->out + OUT_AV; }
            else { nh = 8; hd = (pn - 7) * 4 + wc; vt = (u16*)(ws + (lat ? WS_VTB_LAT : WS_VTB_CTX)); ov = a->out + OUT_BV; }
            const int Tsh = lat ? 10 : 8;
            const int bb = lat ? (pm - 32) >> 2 : pm;
            const unsigned t0 = (unsigned)((lat ? ((pm - 32) & 3) * 256 : 0) + wr * 64 + fr);
            u16* vb = vt + (((size_t)(bb * nh + hd) * 64) << Tsh);
#pragma unroll
            for (int ai = 0; ai < 2; ++ai)
#pragma unroll
                for (int m = 0; m < 4; ++m) {
#pragma unroll
                    for (int bj = 0; bj < 2; ++bj)
#pragma unroll
                        for (int n = 0; n < 2; ++n) { const pg8::f32x4 v = acc[ai][bj][m][n]; const unsigned d = 32 * bj + 16 * n + 4 * fq;
#pragma unroll
                            for (int j = 0; j < 4; ++j) vb[((d + j) << Tsh) + t0 + ai * 128 + m * 16] = bf1(v[j]);
                            if (!lat) *(pg8::f32x4*)(ov + (unsigned)(((row0 + ai * 128 + m * 16) * nh + hd) * 64) + d) = v; }
                    __builtin_amdgcn_sched_barrier(0); }
            return;
        }
        const float* nw; float* ok = nullptr; int nh = 0, hd = 0; bool rope = false;
        if (pn < 2) { nw = a->in[I_QNA]; rope = lat; }
        else if (pn == 2) { nw = a->in[I_KNA]; rope = lat; ok = a->out + OUT_AK; nh = 2; hd = wc; }
        else if (pn < 5) { nw = a->in[I_QNB]; }
        else { nw = a->in[I_KNB]; ok = a->out + OUT_BK; nh = 8; hd = (pn - 5) * 4 + wc; }
        u16* Q = (u16*)(ws + WS_QKV);
        pg8::f32x4 wv[2][2];
#pragma unroll
        for (int bj = 0; bj < 2; ++bj)
#pragma unroll
            for (int n = 0; n < 2; ++n) wv[bj][n] = *(const pg8::f32x4*)(nw + 32 * bj + 16 * n + 4 * fq);
        const float* rtab = (const float*)(ws + WS_ROPE) + fq * 8;
#pragma unroll
        for (int ai = 0; ai < 2; ++ai)
#pragma unroll
            for (int m = 0; m < 4; ++m) {
                const int r = row0 + ai * 128 + m * 16;
                pg8::f32x4 v[2][2]; float ss = 0.f;
#pragma unroll
                for (int bj = 0; bj < 2; ++bj)
#pragma unroll
                    for (int n = 0; n < 2; ++n) { v[bj][n] = acc[ai][bj][m][n]; ss += (v[bj][n][0] * v[bj][n][0] + v[bj][n][1] * v[bj][n][1]) + (v[bj][n][2] * v[bj][n][2] + v[bj][n][3] * v[bj][n][3]); }
                ss += __shfl_xor(ss, 16); ss += __shfl_xor(ss, 32);
                const float rs = rsqrtf(ss * (1.f / 64.f) + RMS_EPS);
#pragma unroll
                for (int bj = 0; bj < 2; ++bj)
#pragma unroll
                    for (int n = 0; n < 2; ++n) v[bj][n] = v[bj][n] * rs * wv[bj][n];
                if (rope) {
                    const int t = (r - NCTX) & 1023;
#pragma unroll
                    for (int bj = 0; bj < 2; ++bj) { const int pos = (bj == 0 ? (t >> 6) : (t & 63));
                        const pg8::f32x4 cs = *(const pg8::f32x4*)(rtab + pos * 32), sn = *(const pg8::f32x4*)(rtab + pos * 32 + 4);
                        const pg8::f32x4 x1 = v[bj][0], x2 = v[bj][1]; v[bj][0] = x1 * cs - x2 * sn; v[bj][1] = x2 * cs + x1 * sn; }
                }
                u16* rp = Q + (size_t)r * QKV_P + pn * 256 + wc * 64 + 4 * fq;
#pragma unroll
                for (int bj = 0; bj < 2; ++bj)
#pragma unroll
                    for (int n = 0; n < 2; ++n) { u32x2 o; o.x = pk2(v[bj][n][0], v[bj][n][1]); o.y = pk2(v[bj][n][2], v[bj][n][3]); *(u32x2*)(rp + 32 * bj + 16 * n) = o;
                        if (ok && !lat) *(pg8::f32x4*)(ok + ((size_t)r * nh + hd) * 64 + 32 * bj + 16 * n + 4 * fq) = v[bj][n]; }
                __builtin_amdgcn_sched_barrier(0);
            }
    }
};

template <int SECOND> struct EpiGate {
    static constexpr bool PERM = false, AFTER_DRAIN = false;
    const Args* a;
    DI void operator()(AccRef acc, const pg8::Unit& u, int wr, int wc, int fr, int fq) const {
        asm volatile("" : "+v"(fr), "+v"(fq));
        unsigned char* ws = a->ws;
        const u16* G = (const u16*)(ws + WS_G) + (SECOND ? 1024 : 0);
        float* TMP = (float*)(ws + WS_TMP); u16* T = (u16*)(ws + WS_T);
        const int row0 = u.pm * 256 + wr * 64 + fr, col0 = u.pn * 256 + wc * 32 + 4 * fq;
#pragma unroll
        for (int ai = 0; ai < 2; ++ai)
#pragma unroll
            for (int m = 0; m < 4; ++m) { const size_t r = row0 + ai * 128 + m * 16;
#pragma unroll
                for (int bj = 0; bj < 2; ++bj)
#pragma unroll
                    for (int n = 0; n < 2; ++n) { const int c = col0 + 128 * bj + 16 * n;
                        const u32x2 gb = *(const u32x2*)(G + r * G_P + c);
                        pg8::f32x4 gv; gv[0] = __uint_as_float(gb.x << 16); gv[1] = __uint_as_float(gb.x & 0xffff0000u); gv[2] = __uint_as_float(gb.y << 16); gv[3] = __uint_as_float(gb.y & 0xffff0000u);
                        pg8::f32x4 v = acc[ai][bj][m][n] * gv;
                        if (!SECOND) *(pg8::f32x4*)(TMP + r * DM + c) = v;
                        else { v += *(const pg8::f32x4*)(TMP + r * DM + c); u32x2 o; o.x = pk2(v[0], v[1]); o.y = pk2(v[2], v[3]); *(u32x2*)(T + r * DM + c) = o; } } }
    }
};

template <int FINAL> struct EpiRes {
    static constexpr bool PERM = false, AFTER_DRAIN = false;
    const Args* a;
    DI void operator()(AccRef acc, const pg8::Unit& u, int wr, int wc, int fr, int fq) const {
        asm volatile("" : "+v"(fr), "+v"(fq));
        const int pm = u.pm; const int grp = pm < 32 ? 0 : 1 + ((pm - 32) >> 2);
        const float* gate = (const float*)(a->ws + WS_CTL) + grp * 6144 + (FINAL ? 5120 : 2048);
        float* out = FINAL ? a->out + OUT_Y : (float*)(a->ws + WS_TMP);
        const float* base = FINAL ? (const float*)(a->ws + WS_TMP) : (pm < 32 ? a->in[I_XP] : a->in[I_XS] - (size_t)NCTX * DM);
        const int row0 = pm * 256 + wr * 64 + fr, col0 = u.pn * 256 + wc * 32 + 4 * fq;
        pg8::f32x4 gv[2][2];
#pragma unroll
        for (int bj = 0; bj < 2; ++bj)
#pragma unroll
            for (int n = 0; n < 2; ++n) gv[bj][n] = *(const pg8::f32x4*)(gate + col0 + 128 * bj + 16 * n);
#pragma unroll
        for (int ai = 0; ai < 2; ++ai)
#pragma unroll
            for (int m = 0; m < 4; ++m) { const size_t r = row0 + ai * 128 + m * 16;
#pragma unroll
                for (int bj = 0; bj < 2; ++bj)
#pragma unroll
                    for (int n = 0; n < 2; ++n) { const int c = col0 + 128 * bj + 16 * n;
                        const pg8::f32x4 b = *(const pg8::f32x4*)(base + r * DM + c);
                        *(pg8::f32x4*)(out + r * DM + c) = b + gv[bj][n] * acc[ai][bj][m][n]; } }
    }
};

struct EpiSwiglu {
    static constexpr bool PERM = false, AFTER_DRAIN = false;
    const Args* a;
    DI void operator()(AccRef acc, const pg8::Unit& u, int wr, int wc, int fr, int fq) const {
        asm volatile("" : "+v"(fr), "+v"(fq));
        u16* GU = (u16*)(a->ws + WS_GU);
        const int row0 = u.pm * 256 + wr * 64 + fr, col0 = u.pn * 128 + wc * 16 + 4 * fq;
#pragma unroll
        for (int ai = 0; ai < 2; ++ai)
#pragma unroll
            for (int m = 0; m < 4; ++m) { const size_t r = row0 + ai * 128 + m * 16;
#pragma unroll
                for (int bj = 0; bj < 2; ++bj) { const pg8::f32x4 g = acc[ai][bj][m][0], up = acc[ai][bj][m][1];
                    u32x2 o; o.x = pk2(siluf_(g[0]) * up[0], siluf_(g[1]) * up[1]); o.y = pk2(siluf_(g[2]) * up[2], siluf_(g[3]) * up[3]);
                    *(u32x2*)(GU + r * DFF + col0 + 64 * bj) = o; } }
    }
};
#define MFMA32(a, b, c) __builtin_amdgcn_mfma_f32_32x32x16_bf16((a), (b), (c), 0, 0, 0)
struct AState { float m, l; f32x16 o0, o1; };
struct AMask { int dq; int e0; const float* bp; };
DI int crow_(int i, int h) { return (i & 3) + 8 * (i >> 2) + 4 * h; }

template <int MODE>
DI void attn_tile(AState& st, const bf16x8 (&qf)[4], const u16* kp, const u16* vp, size_t v32, int h, const AMask& mk) {
    f32x16 s;
#pragma unroll
    for (int i = 0; i < 16; ++i) s[i] = 0.f;
    bf16x8 kf[4];
#pragma unroll
    for (int t = 0; t < 4; ++t) kf[t] = *(const bf16x8*)(kp + 16 * t);
    s16x4 va[2][2][2];
#pragma unroll
    for (int dt = 0; dt < 2; ++dt)
#pragma unroll
        for (int sI = 0; sI < 2; ++sI) { va[dt][sI][0] = *(const s16x4*)(vp + dt * v32 + 16 * sI); va[dt][sI][1] = *(const s16x4*)(vp + dt * v32 + 16 * sI + 8); }
#pragma unroll
    for (int t = 0; t < 4; ++t) s = MFMA32(kf[t], qf[t], s);
    float tmax = -1e30f;
#pragma unroll
    for (int i = 0; i < 16; ++i) {
        float v = s[i] * 0.125f; const int c = crow_(i, h);
        if (MODE == 1) { const int d = mk.dq - c; v = (d <= 128 && d >= -128) ? v : -INFINITY; }
        if (MODE == 2) { const bool ok = (unsigned)(mk.e0 + c) < 16u; const float b = ok ? mk.bp[c] : 0.f; v = ok ? v + b : -INFINITY; }
        s[i] = v; tmax = fmaxf(tmax, v);
    }
    tmax = fmaxf(tmax, __shfl_xor(tmax, 32));
    const float mnew = fmaxf(st.m, tmax), alpha = __expf(st.m - mnew);
    st.m = mnew;
    float psum = 0.f;
#pragma unroll
    for (int i = 0; i < 16; ++i) { const float p = __expf(s[i] - mnew); s[i] = p; psum += p; }
    st.l = st.l * alpha + psum;
#pragma unroll
    for (int i = 0; i < 16; ++i) { st.o0[i] *= alpha; st.o1[i] *= alpha; }
#pragma unroll
    for (int sI = 0; sI < 2; ++sI) {
        u32x4 pw; pw.x = pk2(s[8 * sI], s[8 * sI + 1]); pw.y = pk2(s[8 * sI + 2], s[8 * sI + 3]); pw.z = pk2(s[8 * sI + 4], s[8 * sI + 5]); pw.w = pk2(s[8 * sI + 6], s[8 * sI + 7]);
        const bf16x8 pb = __builtin_bit_cast(bf16x8, pw);
        const bf16x8 a0 = __builtin_shufflevector(va[0][sI][0], va[0][sI][1], 0, 1, 2, 3, 4, 5, 6, 7);
        const bf16x8 a1 = __builtin_shufflevector(va[1][sI][0], va[1][sI][1], 0, 1, 2, 3, 4, 5, 6, 7);
        st.o0 = MFMA32(a0, pb, st.o0);
        st.o1 = MFMA32(a1, pb, st.o1);
    }
}

constexpr int N_ITEMS_LB = 512, N_ITEMS_LA = 512, N_ITEMS_CTX = 4096, N_ITEMS = N_ITEMS_LB + N_ITEMS_LA + N_ITEMS_CTX;

DI void attn_phase(const Args& a, int qi) {
    const int lane = threadIdx.x & 63, r = lane & 31, h = lane >> 5;
    unsigned char* ws = a.ws;
    unsigned* queue = (unsigned*)(ws + WS_CTL + CTL_QUEUE) + 64 * qi;
    const u16* QKV = (const u16*)(ws + WS_QKV);
    for (;;) {
        unsigned it0 = 0;
        if (lane == 0) it0 = atomicAdd(queue, 1u);
        const int it = __builtin_amdgcn_readfirstlane(it0);
        if (it >= N_ITEMS) break;
        AState st;
#pragma unroll
        for (int i = 0; i < 16; ++i) { st.o0[i] = 0.f; st.o1[i] = 0.f; }
        st.m = -1e30f; st.l = 0.f;
        bf16x8 qf[4];
        u16* outp;
        AMask mk; mk.dq = 0; mk.e0 = 0; mk.bp = nullptr;
        if (it < N_ITEMS_LB) {
            const int b = it >> 8, hd = (it >> 5) & 7, qt = it & 31, rq = qt >> 1, c0q = (qt & 1) * 32;
            const size_t tok0 = (size_t)NCTX + b * 1024;
            const u16* qp = QKV + (tok0 + rq * 64 + c0q + r) * QKV_P + 768 + 64 * hd + 8 * h;
#pragma unroll
            for (int t = 0; t < 4; ++t) qf[t] = *(const bf16x8*)(qp + 16 * t);
            const int cq = c0q + r, cs = min(max(cq - 8, 0), 48), rs = min(max(rq - 4, 0), 8);
            const u16* vtb = (const u16*)(ws + WS_VTB_LAT) + ((size_t)(b * 8 + hd) * 64 + r) * 1024 + 4 * h;
            for (int kr = rs; kr < rs + 8; ++kr)
                for (int ct = 0; ct < 2; ++ct) {
                    const int key0 = kr * 64 + ct * 32, kc0 = ct * 32;
                    mk.e0 = kc0 - cs; mk.bp = a.in[I_RPB] + (hd * 15 + (kr - rq + 7)) * 31 + (kc0 - cq + 15);
                    attn_tile<2>(st, qf, QKV + (tok0 + key0 + r) * QKV_P + 1280 + 64 * hd + 8 * h, vtb + key0, (size_t)32 * 1024, h, mk);
                }
            const u16* ck = (const u16*)(ws + WS_CKB) + ((size_t)b * 256 + r) * 512 + 64 * hd + 8 * h;
            const u16* cv = (const u16*)(ws + WS_VCB) + ((size_t)(b * 8 + hd) * 64 + r) * 256 + 4 * h;
            for (int kt = 0; kt < 8; ++kt) attn_tile<0>(st, qf, ck + (size_t)kt * 32 * 512, cv + kt * 32, (size_t)32 * 256, h, mk);
            outp = (u16*)(ws + WS_YB) + (tok0 + rq * 64 + c0q + r) * 512 + 64 * hd;
        } else if (it < N_ITEMS_LB + N_ITEMS_LA) {
            const int i2 = it - N_ITEMS_LB, b = i2 >> 8, hd = (i2 >> 5) & 7, qt = i2 & 31, kvh = hd >> 2;
            const size_t tok0 = (size_t)NCTX + b * 1024;
            const u16* qp = QKV + (tok0 + qt * 32 + r) * QKV_P + 64 * hd + 8 * h;
#pragma unroll
            for (int t = 0; t < 4; ++t) qf[t] = *(const bf16x8*)(qp + 16 * t);
            st.m = a.in[I_SINK][hd]; st.l = h == 0 ? 1.f : 0.f;
            const u16* vtb = (const u16*)(ws + WS_VTA_LAT) + ((size_t)(b * 2 + kvh) * 64 + r) * 1024 + 4 * h;
            const int k_lo = max(qt - 4, 0), k_hi = min(qt + 4, 31);
            for (int kt = k_lo; kt <= k_hi; ++kt) {
                mk.dq = (qt - kt) * 32 + r;
                attn_tile<1>(st, qf, QKV + (tok0 + kt * 32 + r) * QKV_P + 512 + 64 * kvh + 8 * h, vtb + kt * 32, (size_t)32 * 1024, h, mk);
            }
            const u16* ck = (const u16*)(ws + WS_CKA) + ((size_t)b * 256 + r) * 128 + 64 * kvh + 8 * h;
            const u16* cv = (const u16*)(ws + WS_VCA) + ((size_t)(b * 2 + kvh) * 64 + r) * 256 + 4 * h;
            for (int kt = 0; kt < 8; ++kt) attn_tile<0>(st, qf, ck + (size_t)kt * 32 * 128, cv + kt * 32, (size_t)32 * 256, h, mk);
            outp = (u16*)(ws + WS_YA) + (tok0 + qt * 32 + r) * 512 + 64 * hd;
        } else {
            const int i3 = it - N_ITEMS_LB - N_ITEMS_LA, b = i3 >> 7, hh = (i3 >> 3) & 15, qt = i3 & 7;
            const size_t tok0 = (size_t)b * 256;
            const u16 *qp, *kp, *vp;
            if (hh < 8) { const int hd = hh, kvh = hd >> 2;
                qp = QKV + (tok0 + qt * 32 + r) * QKV_P + 64 * hd + 8 * h; kp = QKV + (tok0 + r) * QKV_P + 512 + 64 * kvh + 8 * h;
                vp = (const u16*)(ws + WS_VTA_CTX) + ((size_t)(b * 2 + kvh) * 64 + r) * 256 + 4 * h;
                st.m = a.in[I_SINK][hd]; st.l = h == 0 ? 1.f : 0.f;
                outp = (u16*)(ws + WS_YA) + (tok0 + qt * 32 + r) * 512 + 64 * hd;
            } else { const int hd = hh - 8;
                qp = QKV + (tok0 + qt * 32 + r) * QKV_P + 768 + 64 * hd + 8 * h; kp = QKV + (tok0 + r) * QKV_P + 1280 + 64 * hd + 8 * h;
                vp = (const u16*)(ws + WS_VTB_CTX) + ((size_t)(b * 8 + hd) * 64 + r) * 256 + 4 * h;
                outp = (u16*)(ws + WS_YB) + (tok0 + qt * 32 + r) * 512 + 64 * hd;
            }
#pragma unroll
            for (int t = 0; t < 4; ++t) qf[t] = *(const bf16x8*)(qp + 16 * t);
            for (int kt = 0; kt < 8; ++kt) attn_tile<0>(st, qf, kp + (size_t)kt * 32 * QKV_P, vp + kt * 32, (size_t)32 * 256, h, mk);
        }
        const float l = st.l + __shfl_xor(st.l, 32), inv = 1.f / l;
#pragma unroll
        for (int g = 0; g < 4; ++g) {
            u32x2 o; o.x = pk2(st.o0[4 * g] * inv, st.o0[4 * g + 1] * inv); o.y = pk2(st.o0[4 * g + 2] * inv, st.o0[4 * g + 3] * inv);
            *(u32x2*)(outp + 8 * g + 4 * h) = o;
            o.x = pk2(st.o1[4 * g] * inv, st.o1[4 * g + 1] * inv); o.y = pk2(st.o1[4 * g + 2] * inv, st.o1[4 * g + 3] * inv);
            *(u32x2*)(outp + 32 + 8 * g + 4 * h) = o;
        }
    }
}
constexpr int N_PHASES = 9;
#ifndef DUP_MASK
#define DUP_MASK 0
#endif
__global__ void __launch_bounds__(512, 2) fwd_mega(Args args) {
    extern __shared__ __attribute__((aligned(16))) unsigned char lds_raw[];
    LAS unsigned char* lds = (LAS unsigned char*)lds_raw;
    cg::grid_group grid = cg::this_grid();
    const int lo = args.ph_lo, hi = args.ph_hi;
    unsigned char* ws = args.ws;
#ifndef PHASE_MASK
#define PHASE_MASK 0x1ff
#endif
#define IN(k) (((PHASE_MASK >> (k)) & 1) && lo <= (k) && (k) < hi)
#define SEAM(k) do { if (IN(k) && IN((k) + 1)) xcd_barrier(xb); } while (0)
    if (lo < 0) grid.sync();
    volatile LAS unsigned* xst = (volatile LAS unsigned*)(lds + LDS_XB);
    if (threadIdx.x < 4) xst[threadIdx.x] = 0u;
    __syncthreads();
    XcdBarrier xb; xb.bar = (unsigned*)(ws + WS_CTL + CTL_BAR); xb.x = 0; xb.st = xst;
    if (hi - lo > 1) xb = xcd_barrier_post((unsigned*)(ws + WS_CTL + CTL_BAR), xst);
    if (IN(0)) { p0_prologue(args, lds, true); if (DUP_MASK & 1) p0_prologue(args, lds, false); }
    SEAM(0);
    if (IN(1)) { norm_mod_phase(args, 0); if (DUP_MASK & 2) norm_mod_phase(args, 0); }
    SEAM(1);
    if (DUP_MASK & 512) { for (int q = 0; q < 8; ++q) xcd_barrier(xb); }
    if (IN(2)) {
        pg8::Gemm g{(const pg8::bf16_t*)(ws + WS_H), (const pg8::bf16_t*)(ws + WS_WIN), MTOK, DIN, DM}; pg8::StaticOrder S; S.init(MTOK, DIN, gridDim.x, blockIdx.x, (DUP_MASK & 4) ? 2 : 1);
        EpiIn E{&args};
        pg8::gemm_phase<EpiIn, pg8::StaticOrder, true, true>(lds, g, S, E);
    }
    SEAM(2);
    if (IN(3)) { attn_phase(args, 0); if (DUP_MASK & 8) attn_phase(args, 1); }
    SEAM(3);
    if (IN(4)) {
        pg8::StaticOrder S; S.init(MTOK, DM, gridDim.x, blockIdx.x, (DUP_MASK & 16) ? 2 : 1);
        { pg8::Gemm g{(const pg8::bf16_t*)(ws + WS_YA), (const pg8::bf16_t*)(ws + WS_WOA), MTOK, DM, 512}; EpiGate<0> E{&args};
          pg8::gemm_phase<EpiGate<0>, pg8::StaticOrder, true, true>(lds, g, S, E); }
        { pg8::Gemm g{(const pg8::bf16_t*)(ws + WS_YB), (const pg8::bf16_t*)(ws + WS_WOB), MTOK, DM, 512}; EpiGate<1> E{&args};
          pg8::gemm_phase<EpiGate<1>, pg8::StaticOrder, true, true>(lds, g, S, E); }
    }
    SEAM(4);
    if (IN(5)) {
        pg8::Gemm g{(const pg8::bf16_t*)(ws + WS_T), (const pg8::bf16_t*)(ws + WS_WO), MTOK, DM, DM}; pg8::StaticOrder S; S.init(MTOK, DM, gridDim.x, blockIdx.x, (DUP_MASK & 32) ? 2 : 1);
        EpiRes<0> E{&args};
        pg8::gemm_phase<EpiRes<0>, pg8::StaticOrder, true, true>(lds, g, S, E);
    }
    SEAM(5);
    if (IN(6)) { norm_mod_phase(args, 1); if (DUP_MASK & 64) norm_mod_phase(args, 1); }
    SEAM(6);
    if (IN(7)) {
        pg8::Gemm g{(const pg8::bf16_t*)(ws + WS_H), (const pg8::bf16_t*)(ws + WS_WGU), MTOK, NGU, DM}; pg8::StaticOrder S; S.init(MTOK, NGU, gridDim.x, blockIdx.x, (DUP_MASK & 128) ? 2 : 1);
        EpiSwiglu E{&args};
        pg8::gemm_phase<EpiSwiglu, pg8::StaticOrder, true, true>(lds, g, S, E);
    }
    SEAM(7);
    if (IN(8)) {
        pg8::Gemm g{(const pg8::bf16_t*)(ws + WS_GU), (const pg8::bf16_t*)(ws + WS_WD), MTOK, DM, DFF}; pg8::StaticOrder S; S.init(MTOK, DM, gridDim.x, blockIdx.x, (DUP_MASK & 256) ? 2 : 1);
        EpiRes<1> E{&args};
        pg8::gemm_phase<EpiRes<1>, pg8::StaticOrder, true, true>(lds, g, S, E);
    }
#undef IN
#undef SEAM
}

#ifndef N_LAUNCH_MODE
#define N_LAUNCH_MODE 1
#endif
extern "C" void kernel_launch(void* const* d_in, const int* in_sizes, int n_in, void* d_out, int out_size, void* d_ws, size_t ws_size, hipStream_t stream) {
    static int grid = 0;
    if (grid == 0) {
        int dev = 0, cus = 0, per_cu = 0;
        (void)hipGetDevice(&dev);
        (void)hipDeviceGetAttribute(&cus, hipDeviceAttributeMultiprocessorCount, dev);
        (void)hipFuncSetAttribute((const void*)fwd_mega, hipFuncAttributeMaxDynamicSharedMemorySize, LDS_BYTES);
        (void)hipOccupancyMaxActiveBlocksPerMultiprocessor(&per_cu, (const void*)fwd_mega, 512, LDS_BYTES);
        if (per_cu < 1) { fprintf(stderr, "occupancy query says %d blocks/CU\n", per_cu); per_cu = 1; }
        grid = cus * per_cu;
        if (n_in != 25) fprintf(stderr, "kernel_launch: expected 25 inputs, got %d\n", n_in);
    }
    (void)hipMemsetAsync((char*)d_ws + WS_CTL, 0, CTL_BYTES, stream);
    Args a{};
    for (int i = 0; i < 25; ++i) a.in[i] = (const float*)d_in[i];
    a.out = (float*)d_out; a.ws = (unsigned char*)d_ws;
    if (N_LAUNCH_MODE == 1) {
        a.ph_lo = 0; a.ph_hi = N_PHASES;
        void* kargs[] = {&a};
        hipError_t e = hipLaunchCooperativeKernel((const void*)fwd_mega, dim3(grid), dim3(512), kargs, LDS_BYTES, stream);
        if (e != hipSuccess) fprintf(stderr, "cooperative launch failed: %s (grid %d)\n", hipGetErrorString(e), grid);
    } else {
        for (int p = 0; p < N_PHASES; ++p) { a.ph_lo = p; a.ph_hi = p + 1; hipLaunchKernelGGL(fwd_mega, dim3(grid), dim3(512), LDS_BYTES, stream, a); }
    }
}
```

```cpp
#include <hip/hip_runtime.h>
#include <hip/hip_cooperative_groups.h>
#include <cstdio>
#include <cstdint>
namespace cg = cooperative_groups;
namespace pg8 {
#define PG8_LAS __attribute__((address_space(3)))
typedef unsigned short bf16_t;
typedef short bf16x8 __attribute__((ext_vector_type(8)));
typedef float f32x4 __attribute__((ext_vector_type(4)));
typedef unsigned u32x4 __attribute__((ext_vector_type(4)));
constexpr int BM = 256, BK = 64, HALF = 128, HTB = HALF * BK * 2  , STAGE_BYTES = 8 * HTB, NXCD = 8, WGM = 4;

__host__ __device__ __forceinline__ int lds_byte(int r, int c) { const int st = (r >> 4) * 2 + (c >> 5), rr = r & 15, cc = c & 31, ob = rr * 64 + cc * 2; return st * 1024 + (ob ^ (((ob >> 9) & 1) << 5)); }
__host__ __device__ __forceinline__ void stage_rc(int b, int& R, int& C) { const int st = b / 1024, sb = b % 1024, swz = sb ^ (((sb >> 9) & 1) << 5); R = (st >> 1) * 16 + swz / 64; C = (st & 1) * 32 + (swz % 64) / 2; }
__host__ __device__ __forceinline__ int perm32(int rho) { const int n = rho >> 4, i = rho & 15; return 8 * (i >> 2) + 4 * n + (i & 3); }

struct Unit { int pm, pn; };
struct Gemm { const bf16_t* A; const bf16_t* Bt; int M, N, K; };

struct StaticOrder {
    int nM, nN, nwg, G, c, reps;
    __host__ __device__ void init(int M, int N, int G_, int c_, int reps_ = 1) { nM = M / BM; nN = N / BM; nwg = nM * nN; G = G_; c = c_; reps = reps_; }
    __host__ __device__ bool next(int i, Unit& u) const {
        const long L = (long)(i / reps) * G + c; if (L >= nwg) return false;
        int wgid = (int)L; { const int q = nwg / NXCD, r = nwg % NXCD, xcd = wgid % NXCD, off = wgid / NXCD; wgid = (xcd < r ? xcd * (q + 1) : r * (q + 1) + (xcd - r) * q) + off; }
        const int nig = WGM * nN, gid = wgid / nig, fm = gid * WGM, gsz = (nM - fm) < WGM ? (nM - fm) : WGM;
        u.pm = fm + ((wgid % nig) % gsz); u.pn = (wgid % nig) / gsz; return true;
    }
    __device__ __forceinline__ void a_ready(const Unit&) const {}
    __device__ __forceinline__ void done(const Unit&) const {}
};

__device__ __forceinline__ unsigned cvt_pk_bf16(float lo, float hi) { unsigned r; asm volatile("v_cvt_pk_bf16_f32 %0, %1, %2" : "=v"(r) : "v"(lo), "v"(hi)); return r; }

template <class Epi, class Sched, bool ALIGN_EPI = false, bool SP2 = false>
__device__ __forceinline__ void gemm_phase(PG8_LAS unsigned char* lds, const Gemm g, const Sched& S, const Epi& E) {
    int tid_ = threadIdx.x; asm volatile("" : "+v"(tid_));
    const int tid = tid_, wid = __builtin_amdgcn_readfirstlane(tid >> 6), lane = tid & 63, wr = wid >> 2, wc = wid & 3, fr = lane & 15, fq = lane >> 4;
    const int K = g.K, nt = K / BK;
    unsigned voffA[2], voffB[2];
#pragma unroll
    for (int i = 0; i < 2; ++i) { int R, C; stage_rc(tid * 16 + i * 8192, R, C); const int Rb = Epi::PERM ? ((R & ~31) + perm32(R & 31)) : R;
        voffA[i] = (unsigned)(R * K + C) * 2u; voffB[i] = (unsigned)(Rb * K + C) * 2u; }
    const size_t kstep = (size_t)(BK * 2);
    const size_t hstep = (size_t)HALF * K * 2;
    const size_t tstep = 2 * hstep;
    const unsigned ldsw = (unsigned)wid * 1024u;
    const int aoff = lds_byte(wr * 64 + fr, fq * 8), boff = lds_byte(wc * 32 + fr, fq * 8);
#define PG8_SA(b, h) (((b) * 2 + (h)) * HTB)
#define PG8_SB(b, h) ((4 + (b) * 2 + (h)) * HTB)
#define PG8_STAGE(bufoff, gbase, voff) do { _Pragma("unroll") for (int _i = 0; _i < 2; ++_i) \
        __builtin_amdgcn_global_load_lds((const unsigned*)((const char*)(gbase) + (voff)[_i]), (PG8_LAS unsigned*)(lds + (bufoff) + ldsw + _i * 8192), 16, 0, 0); } while (0)
#define PG8_LDA(dst, b, h) do { _Pragma("unroll") for (int m = 0; m < 4; ++m) _Pragma("unroll") for (int k = 0; k < 2; ++k) dst[m][k] = *(const PG8_LAS bf16x8*)(lds + PG8_SA(b, h) + aoff + m * 2048 + k * 1024); } while (0)
#define PG8_LDB(dst, b, h) do { _Pragma("unroll") for (int n = 0; n < 2; ++n) _Pragma("unroll") for (int k = 0; k < 2; ++k) dst[n][k] = *(const PG8_LAS bf16x8*)(lds + PG8_SB(b, h) + boff + n * 2048 + k * 1024); } while (0)
#define PG8_MMA(ai, bj, At, Bt) do { __builtin_amdgcn_s_setprio(1); _Pragma("unroll") for (int m = 0; m < 4; ++m) _Pragma("unroll") for (int n = 0; n < 2; ++n) _Pragma("unroll") for (int k = 0; k < 2; ++k) \
        acc[ai][bj][m][n] = __builtin_amdgcn_mfma_f32_16x16x32_bf16(Bt[n][k], At[m][k], acc[ai][bj][m][n], 0, 0, 0); __builtin_amdgcn_s_setprio(0); } while (0)
#define PG8_WAIT_V(n) asm volatile("s_waitcnt vmcnt(" #n ")" ::: "memory")
#define PG8_WAIT_L(n) asm volatile("s_waitcnt lgkmcnt(" #n ")" ::: "memory")
#define PG8_BAR __builtin_amdgcn_s_barrier()
#define PG8_SCHED __builtin_amdgcn_sched_barrier(0)
    Unit cur, nxt; int ui = 0;
    if (!S.next(0, cur)) return;
    f32x4 acc[2][2][4][2];
#pragma unroll
    for (int a = 0; a < 2; ++a)
#pragma unroll
        for (int b = 0; b < 2; ++b)
#pragma unroll
            for (int m = 0; m < 4; ++m)
#pragma unroll
                for (int n = 0; n < 2; ++n) acc[a][b][m][n] = (f32x4){0.f, 0.f, 0.f, 0.f};
    bf16x8 At[4][2], B0[2][2], B1[2][2];
    const char* cA = (const char*)g.A + (size_t)cur.pm * tstep; const char* cB = (const char*)g.Bt + (size_t)cur.pn * tstep;
    S.a_ready(cur);
    if constexpr (SP2) {
        PG8_STAGE(PG8_SB(0, 0), cB, voffB); PG8_STAGE(PG8_SB(0, 1), cB + hstep, voffB); PG8_STAGE(PG8_SA(0, 0), cA, voffA); PG8_STAGE(PG8_SA(0, 1), cA + hstep, voffA);
        if (wr == 1) PG8_BAR;
        PG8_WAIT_V(2); PG8_BAR;
        PG8_STAGE(PG8_SB(1, 0), cB + kstep, voffB); PG8_STAGE(PG8_SA(1, 0), cA + kstep, voffA); PG8_STAGE(PG8_SB(1, 1), cB + hstep + kstep, voffB);
        PG8_WAIT_V(6); PG8_BAR;
    } else {
        PG8_STAGE(PG8_SB(0, 0), cB, voffB); PG8_STAGE(PG8_SA(0, 0), cA, voffA); PG8_STAGE(PG8_SB(0, 1), cB + hstep, voffB); PG8_STAGE(PG8_SA(0, 1), cA + hstep, voffA);
        if (wr == 1) PG8_BAR;
        PG8_WAIT_V(4); PG8_BAR;
        PG8_STAGE(PG8_SB(1, 0), cB + kstep, voffB); PG8_STAGE(PG8_SA(1, 0), cA + kstep, voffA); PG8_STAGE(PG8_SB(1, 1), cB + hstep + kstep, voffB);
        PG8_WAIT_V(6); PG8_BAR;
    }
    for (;;) {
        const bool has_next = S.next(ui + 1, nxt);
        const char* nA = has_next ? (const char*)g.A + (size_t)nxt.pm * tstep : cA; const char* nB = has_next ? (const char*)g.Bt + (size_t)nxt.pn * tstep : cB;
        for (int t = 0; t < nt; t += 2) {
            const bool last = (t == nt - 2);
            const char* a1 = cA + (size_t)(t + 1) * kstep;
            const char* a2 = last ? nA : cA + (size_t)(t + 2) * kstep; const char* b2 = last ? nB : cB + (size_t)(t + 2) * kstep;
            const char* a3 = a2 + kstep; const char* b3 = b2 + kstep;
            if (last && has_next) S.a_ready(nxt);
            if constexpr (Epi::HAS_MID) { if (t == Epi::MID_T) E.mid(acc, cur, wr, wc, fr, fq); }
            if constexpr (SP2) {
            PG8_LDB(B0, 0, 0); PG8_LDB(B1, 0, 1); PG8_SCHED; PG8_LDA(At, 0, 0); PG8_STAGE(PG8_SA(1, 1), a1 + hstep, voffA);
            PG8_WAIT_V(8); PG8_WAIT_L(0); PG8_BAR; PG8_MMA(0, 0, At, B0); PG8_MMA(0, 1, At, B1); PG8_BAR; PG8_SCHED;
            PG8_LDA(At, 0, 1); PG8_STAGE(PG8_SB(0, 0), b2, voffB); PG8_STAGE(PG8_SB(0, 1), b2 + hstep, voffB); PG8_STAGE(PG8_SA(0, 0), a2, voffA);
            PG8_WAIT_V(8); PG8_WAIT_L(0); PG8_BAR; PG8_MMA(1, 0, At, B0); PG8_MMA(1, 1, At, B1); PG8_BAR; PG8_SCHED;
            PG8_LDB(B0, 1, 0); PG8_LDB(B1, 1, 1); PG8_SCHED; PG8_LDA(At, 1, 0); PG8_STAGE(PG8_SA(0, 1), a2 + hstep, voffA);
            PG8_WAIT_V(8); PG8_WAIT_L(0); PG8_BAR; PG8_MMA(0, 0, At, B0); PG8_MMA(0, 1, At, B1); PG8_BAR; PG8_SCHED;
            PG8_LDA(At, 1, 1); PG8_STAGE(PG8_SB(1, 0), b3, voffB); PG8_STAGE(PG8_SB(1, 1), b3 + hstep, voffB); PG8_STAGE(PG8_SA(1, 0), a3, voffA);
            PG8_WAIT_V(8); PG8_WAIT_L(0); PG8_BAR; PG8_MMA(1, 0, At, B0); PG8_MMA(1, 1, At, B1); PG8_BAR; PG8_SCHED;
            } else {
            PG8_LDB(B0, 0, 0); PG8_SCHED; PG8_LDA(At, 0, 0); PG8_STAGE(PG8_SA(1, 1), a1 + hstep, voffA);
            PG8_WAIT_L(8); PG8_BAR; PG8_WAIT_L(0); PG8_MMA(0, 0, At, B0); PG8_BAR; PG8_SCHED;
            PG8_LDB(B1, 0, 1); PG8_STAGE(PG8_SB(0, 0), b2, voffB);
            PG8_BAR; PG8_WAIT_L(0); PG8_MMA(0, 1, At, B1); PG8_BAR;
            PG8_LDA(At, 0, 1); PG8_STAGE(PG8_SA(0, 0), a2, voffA);
            PG8_BAR; PG8_WAIT_L(0); PG8_MMA(1, 0, At, B0); PG8_BAR; PG8_SCHED;
            PG8_STAGE(PG8_SB(0, 1), b2 + hstep, voffB);
            PG8_WAIT_V(6); PG8_BAR; PG8_MMA(1, 1, At, B1); PG8_BAR;
            PG8_LDB(B0, 1, 0); PG8_SCHED; PG8_LDA(At, 1, 0); PG8_STAGE(PG8_SA(0, 1), a2 + hstep, voffA);
            PG8_WAIT_L(8); PG8_BAR; PG8_WAIT_L(0); PG8_MMA(0, 0, At, B0); PG8_BAR; PG8_SCHED;
            PG8_LDB(B1, 1, 1); PG8_STAGE(PG8_SB(1, 0), b3, voffB);
            PG8_BAR; PG8_WAIT_L(0); PG8_MMA(0, 1, At, B1); PG8_BAR;
            PG8_LDA(At, 1, 1); PG8_STAGE(PG8_SA(1, 0), a3, voffA);
            PG8_BAR; PG8_WAIT_L(0); PG8_MMA(1, 0, At, B0); PG8_BAR; PG8_SCHED;
            PG8_STAGE(PG8_SB(1, 1), b3 + hstep, voffB);
            PG8_WAIT_V(6); PG8_BAR; PG8_MMA(1, 1, At, B1); PG8_BAR;
            }
        }
        if constexpr (ALIGN_EPI) { if (wr == 0) PG8_BAR; }
        if constexpr (!Epi::AFTER_DRAIN) { E(acc, cur, wr, wc, fr, fq); S.done(cur); }
        if (!has_next) break;
#pragma unroll
        for (int a = 0; a < 2; ++a)
#pragma unroll
            for (int b = 0; b < 2; ++b)
#pragma unroll
                for (int m = 0; m < 4; ++m)
#pragma unroll
                    for (int n = 0; n < 2; ++n) acc[a][b][m][n] = (f32x4){0.f, 0.f, 0.f, 0.f};
        cur = nxt; cA = nA; cB = nB; ++ui;
        if constexpr (ALIGN_EPI) { if (wr == 1) PG8_BAR; }
    }
    PG8_WAIT_V(0);
    if constexpr (!ALIGN_EPI) { if (wr == 0) PG8_BAR; }
    PG8_BAR;
    if constexpr (Epi::AFTER_DRAIN) { E.fused(acc, cur, wr, wc, fr, fq, lds, wid, lane); S.done(cur); }
#undef PG8_SA
#undef PG8_SB
#undef PG8_STAGE
#undef PG8_LDA
#undef PG8_LDB
#undef PG8_MMA
#undef PG8_WAIT_V
#undef PG8_WAIT_L
#undef PG8_BAR
#undef PG8_SCHED
}
}

#define DI __device__ __forceinline__
#define LAS __attribute__((address_space(3)))
typedef unsigned short u16;
typedef float f32x4 __attribute__((ext_vector_type(4)));
typedef float f32x16 __attribute__((ext_vector_type(16)));
typedef float f32x2 __attribute__((ext_vector_type(2)));
typedef short bf16x8 __attribute__((ext_vector_type(8)));
typedef short s16x4 __attribute__((ext_vector_type(4)));
typedef unsigned u32x2 __attribute__((ext_vector_type(2)));
typedef unsigned u32x4 __attribute__((ext_vector_type(4)));
typedef __bf16 bf16x2_t __attribute__((ext_vector_type(2)));

constexpr int DM = 1024, NCTX = 8192, NLAT = 2048, MTOK = 10240, DIN = 4352, DFF = 2816, NGU = 2 * DFF;
constexpr int QKV_P = 2304, G_P = 2048;
constexpr size_t MiB = 1u << 20;
constexpr size_t WS_CTL = 0, CTL_BYTES = 128 * 1024, CTL_QUEUE = 81920;
constexpr size_t CTL_BAR = 90112;
constexpr size_t CTL_ADAFLAG = 86016;
constexpr size_t CTL_PANEL = 104448;
constexpr size_t WS_ROPE = 512 * 1024;
constexpr size_t WS_SHW = 640 * 1024;
constexpr size_t WS_RSS = 231 * MiB;
constexpr size_t WS_WIN = 1 * MiB, WS_WOA = 10 * MiB, WS_WOB = 11 * MiB, WS_WO = 12 * MiB, WS_WGU = 14 * MiB, WS_WD = 25 * MiB;
constexpr size_t WS_CKA = 31 * MiB, WS_CKB = 31 * MiB + 128 * 1024, WS_VCA = 32 * MiB, WS_VCB = 32 * MiB + 128 * 1024;
constexpr size_t WS_VTA_CTX = 33 * MiB, WS_VTB_CTX = 35 * MiB, WS_VTA_LAT = 43 * MiB, WS_VTB_LAT = 44 * MiB;
constexpr size_t WS_H = 46 * MiB, WS_QKV = 66 * MiB, WS_G = 111 * MiB, WS_YA = 151 * MiB, WS_YB = 161 * MiB, WS_TMP = 171 * MiB, WS_T = 211 * MiB, WS_GU = 66 * MiB;
constexpr size_t OUT_Y = 0, OUT_AK = 10485760, OUT_AV = 11534336, OUT_BK = 12582912, OUT_BV = 16777216;
constexpr int LDS_BYTES = 147456, LDS_XB = 147456 - 64;
constexpr float RMS_EPS = 1e-6f;

DI unsigned pk2(float lo, float hi) { f32x2 v = {lo, hi}; bf16x2_t b = __builtin_convertvector(v, bf16x2_t); return __builtin_bit_cast(unsigned, b); }
DI u16 bf1(float x) { return (u16)(pk2(x, 0.f) & 0xffffu); }
DI float wave_sum(float v) {
#pragma unroll
    for (int o = 1; o < 64; o <<= 1) v += __shfl_xor(v, o);
    return v;
}
DI float sigmoidf_(float x) { return 1.0f / (1.0f + __expf(-x)); }
DI float siluf_(float x) { return x / (1.0f + __expf(-x)); }

struct Args { const float* in[25]; float* out; unsigned char* ws; int ph_lo, ph_hi; };
enum { I_XP = 0, I_XS, I_CAK, I_CAV, I_CBK, I_CBV, I_C, I_CCTX, I_WADA, I_BADA, I_GATTN, I_WIN, I_QNA, I_KNA, I_QNB, I_KNB, I_SINK, I_RPB, I_WOA, I_WOB, I_WO, I_GFFN, I_WG, I_WU, I_WD };

DI int dest_row(int mode, int n) {
    if (mode == 0) return n;
    if (mode == 1) { const int pn = n >> 8, wc = (n >> 6) & 3, bj = (n >> 5) & 1, e = n & 31; return (pn << 8) + (bj << 7) + (wc << 5) + e; }
    const int pn = n >> 7, rem = n & 127, bj = rem >> 6, wc = (rem >> 4) & 3, e = rem & 15;
    return (pn << 8) + (bj << 7) + (wc << 5) + ((mode == 3) ? 16 : 0) + e;
}
DI void p0_transpose_block(const float* W, int K, int N, u16* WT, int mode, LAS float* scr, int item, int tid, int ldk = 0, int koff = 0) {
    if (ldk == 0) ldk = K;
    const int nblk = N / 256, kb = item / nblk, nb = item % nblk, k0 = 64 * kb, n0 = 256 * nb;
    const int lane = tid & 63, wave = tid >> 6;
#pragma unroll
    for (int i = 0; i < 8; ++i) { const int kk = wave * 8 + i; const f32x4 v = *(const f32x4*)(W + (size_t)(k0 + kk) * N + n0 + 4 * lane);
        LAS float* d = scr + kk * 257 + 4 * lane; d[0] = v.x; d[1] = v.y; d[2] = v.z; d[3] = v.w; }
    __syncthreads();
    const int c = lane & 7;
#pragma unroll
    for (int j = 0; j < 4; ++j) { const int n = wave * 32 + j * 8 + (lane >> 3); const LAS float* sp = scr + (8 * c) * 257 + n;
        u32x4 o; o.x = pk2(sp[0 * 257], sp[1 * 257]); o.y = pk2(sp[2 * 257], sp[3 * 257]); o.z = pk2(sp[4 * 257], sp[5 * 257]); o.w = pk2(sp[6 * 257], sp[7 * 257]);
        *(u32x4*)(WT + (size_t)dest_row(mode, n0 + n) * ldk + koff + k0 + 8 * c) = o; }
    __syncthreads();
}

constexpr int LATE_MIN_GRID = 192;
DI void p0_late_transposes(const Args& a, LAS unsigned char* lds, int which, int first, int stride) {
    LAS float* scr = (LAS float*)lds; unsigned char* ws = a.ws; int tid = threadIdx.x; asm volatile("" : "+v"(tid));
    constexpr int I_OA = 8 * 4, I_OB = 8 * 4, I_O = 16 * 4, I_G = 16 * (DFF / 256), I_U = I_G, I_D = (DFF / 64) * 4;
    if (which == 0) for (int it = first; it < I_OA + I_OB + I_O; it += stride) {
        int r = it;
        if (r < I_OA) { p0_transpose_block(a.in[I_WOA], 512, DM, (u16*)(ws + WS_WOA), 0, scr, r, tid, 1024, 0); continue; } r -= I_OA;
        if (r < I_OB) { p0_transpose_block(a.in[I_WOB], 512, DM, (u16*)(ws + WS_WOA), 0, scr, r, tid, 1024, 512); continue; } r -= I_OB;
        p0_transpose_block(a.in[I_WO], DM, DM, (u16*)(ws + WS_WO), 0, scr, r, tid);
    }
    if (which == 1) for (int it = first; it < I_G + I_U; it += stride) {
        if (it < I_G) p0_transpose_block(a.in[I_WG], DM, DFF, (u16*)(ws + WS_WGU), 2, scr, it, tid);
        else p0_transpose_block(a.in[I_WU], DM, DFF, (u16*)(ws + WS_WGU), 3, scr, it - I_G, tid);
    }
    if (which == 2) for (int it = first; it < I_D; it += stride) p0_transpose_block(a.in[I_WD], DFF, DM, (u16*)(ws + WS_WD), 0, scr, it, tid);
}
DI void shw_rows(const Args& a, int first, int stride) {
    int tid_ = threadIdx.x; asm volatile("" : "+v"(tid_));
    const int lane = tid_ & 63, wave = tid_ >> 6;
    const float* ada = (const float*)(a.ws + WS_CTL); const u16* W = (const u16*)(a.ws + WS_WGU); float* shw = (float*)(a.ws + WS_SHW);
    f32x4 sh[3][4];
#pragma unroll
    for (int g = 0; g < 3; ++g)
#pragma unroll
        for (int q = 0; q < 4; ++q) sh[g][q] = *(const f32x4*)(ada + g * 6144 + 3072 + 16 * lane + 4 * q);
    for (int n = first * 8 + wave; n < NGU; n += stride * 8) {
        const u32x4 w0 = *(const u32x4*)(W + (size_t)n * DM + 16 * lane), w1 = *(const u32x4*)(W + (size_t)n * DM + 16 * lane + 8);
        const unsigned ww[8] = {w0.x, w0.y, w0.z, w0.w, w1.x, w1.y, w1.z, w1.w};
        float d0 = 0.f, d1 = 0.f, d2 = 0.f;
#pragma unroll
        for (int q = 0; q < 8; ++q) { const float lo = __uint_as_float(ww[q] << 16), hi = __uint_as_float(ww[q] & 0xffff0000u); const int e = 2 * q;
            d0 += lo * sh[0][e >> 2][e & 3] + hi * sh[0][(e + 1) >> 2][(e + 1) & 3];
            d1 += lo * sh[1][e >> 2][e & 3] + hi * sh[1][(e + 1) >> 2][(e + 1) & 3];
            d2 += lo * sh[2][e >> 2][e & 3] + hi * sh[2][(e + 1) >> 2][(e + 1) & 3]; }
        d0 = wave_sum(d0); d1 = wave_sum(d1); d2 = wave_sum(d2);
        if (lane == 0) { shw[n] = d0; shw[NGU + n] = d1; shw[2 * NGU + n] = d2; }
    }
}
DI void p0_prologue(const Args& a, LAS unsigned char* lds, bool do_ada) {
    (void)do_ada;
    int tid_ = threadIdx.x; asm volatile("" : "+v"(tid_));
    const int tid = tid_, lane = tid & 63, wave = __builtin_amdgcn_readfirstlane(tid >> 6);
    const int gw = blockIdx.x * 8 + wave, NGW = gridDim.x * 8;
    unsigned char* ws = a.ws;
    float* ada = (float*)(ws + WS_CTL);
    {
        LAS float* red = (LAS float*)lds;
        for (int it = blockIdx.x; it < 24 * 8; it += gridDim.x) {
            const int cgp = it % 24, kc = it / 24, col = cgp * 256 + 4 * lane, kbase = kc * 128 + wave * 16;
            const float* wp = a.in[I_WADA] + (size_t)kbase * 6144 + col;
            f32x4 acc0 = {0, 0, 0, 0}, acc1 = acc0, acc2 = acc0;
#pragma unroll
            for (int k = 0; k < 16; ++k) {
                const f32x4 w = *(const f32x4*)(wp + (size_t)k * 6144);
                const int kk = kbase + k;
                const float s0 = siluf_(a.in[I_CCTX][kk]), s1 = siluf_(a.in[I_C][kk]), s2 = siluf_(a.in[I_C][1024 + kk]);
                acc0 += w * s0; acc1 += w * s1; acc2 += w * s2;
            }
#pragma unroll
            for (int j = 0; j < 4; ++j) { red[(wave * 3 + 0) * 256 + 4 * lane + j] = acc0[j]; red[(wave * 3 + 1) * 256 + 4 * lane + j] = acc1[j]; red[(wave * 3 + 2) * 256 + 4 * lane + j] = acc2[j]; }
            __syncthreads();
            for (int idx = tid; idx < 768; idx += 512) { const int v = idx >> 8, c = idx & 255; float t = kc == 0 ? a.in[I_BADA][cgp * 256 + c] : 0.f;
#pragma unroll
                for (int q = 0; q < 8; ++q) t += red[(q * 3 + v) * 256 + c];
                atomicAdd(ada + v * 6144 + cgp * 256 + c, t); }
            __syncthreads();
        }
    }
    if (tid == 0 && (int)blockIdx.x < 24 * 8) { __threadfence(); atomicAdd((unsigned*)(ws + WS_CTL + CTL_ADAFLAG), 1u); }
    {
        LAS float* scr = (LAS float*)lds;
        constexpr int I_IN = 16 * (DIN / 256);
        for (int it = gridDim.x - 1 - blockIdx.x; it < I_IN; it += gridDim.x) p0_transpose_block(a.in[I_WIN], DM, DIN, (u16*)(ws + WS_WIN), 1, scr, it, tid);
        if ((int)gridDim.x < LATE_MIN_GRID) { p0_late_transposes(a, lds, 0, blockIdx.x, gridDim.x); p0_late_transposes(a, lds, 1, blockIdx.x, gridDim.x); p0_late_transposes(a, lds, 2, blockIdx.x, gridDim.x); }
    }
    if (blockIdx.x == 0) { for (int i = tid; i < 64 * 16; i += 512) { const int pos = i >> 4, fi = i & 15; const float ang = (float)pos * exp2f(-(float)fi * (13.287712379549449f / 16.0f));
        float* rt = (float*)(ws + WS_ROPE) + (pos * 4 + (fi >> 2)) * 8 + (fi & 3); rt[0] = cosf(ang); rt[4] = sinf(ang); } }
    const int gt = blockIdx.x * 512 + tid, NGT = gridDim.x * 512;
    for (int i = gt; i < 2 * 256 * 128 / 4; i += NGT) { const f32x4 v = *(const f32x4*)(a.in[I_CAK] + 4 * i); u32x2 o; o.x = pk2(v.x, v.y); o.y = pk2(v.z, v.w); *(u32x2*)((u16*)(ws + WS_CKA) + 4 * i) = o; }
    for (int i = gt; i < 2 * 256 * 512 / 4; i += NGT) { const f32x4 v = *(const f32x4*)(a.in[I_CBK] + 4 * i); u32x2 o; o.x = pk2(v.x, v.y); o.y = pk2(v.z, v.w); *(u32x2*)((u16*)(ws + WS_CKB) + 4 * i) = o; }
    for (int it = gw; it < 128 + 512; it += NGW) {
        const bool isA = it < 128; const int j = isA ? it : it - 128, nh = isA ? 2 : 8;
        const int g = j & 31, hd = (j >> 5) % nh, b = (j >> 5) / nh;
        const float* src = a.in[isA ? I_CAV : I_CBV] + ((size_t)(b * 256 + 8 * g) * nh + hd) * 64 + lane;
        float v[8];
#pragma unroll
        for (int q = 0; q < 8; ++q) v[q] = src[(size_t)q * nh * 64];
        u32x4 o; o.x = pk2(v[0], v[1]); o.y = pk2(v[2], v[3]); o.z = pk2(v[4], v[5]); o.w = pk2(v[6], v[7]);
        *(u32x4*)((u16*)(ws + (isA ? WS_VCA : WS_VCB)) + ((size_t)(b * nh + hd) * 64 + lane) * 256 + 8 * g) = o;
    }
}

DI void norm_mod_phase(const Args& a, int which) {
    int tid_ = threadIdx.x; asm volatile("" : "+v"(tid_));
    const int tid = tid_, lane = tid & 63, wave = tid >> 6;
    if (which == 0) {
        if (tid == 0) { const unsigned want = (unsigned)min(24 * 8, (int)gridDim.x); unsigned* f = (unsigned*)(a.ws + WS_CTL + CTL_ADAFLAG); unsigned sp = 0;
            while (__hip_atomic_load(f, __ATOMIC_RELAXED, __HIP_MEMORY_SCOPE_AGENT) < want && ++sp < (1u << 22)) __builtin_amdgcn_s_sleep(2);
            __builtin_amdgcn_fence(__ATOMIC_ACQUIRE, "agent"); asm volatile("s_waitcnt vmcnt(0)" ::: "memory"); }
        __syncthreads();
    }
    const int gw = blockIdx.x * 8 + wave, NGW = gridDim.x * 8;
    const float* ada = (const float*)(a.ws + WS_CTL);
    const float* g = a.in[which ? I_GFFN : I_GATTN];
    u16* H = (u16*)(a.ws + WS_H);
    constexpr int RB = 5;
    for (int r0 = gw; r0 < MTOK; r0 += RB * NGW) {
        f32x4 v[RB][4];
#pragma unroll
        for (int i = 0; i < RB; ++i) { const int r = r0 + i * NGW;
            if (r < MTOK) { const float* xrow = which ? ((const float*)(a.ws + WS_TMP) + (size_t)r * DM) : (r < NCTX ? a.in[I_XP] + (size_t)r * DM : a.in[I_XS] + (size_t)(r - NCTX) * DM);
#pragma unroll
                for (int j = 0; j < 4; ++j) v[i][j] = *(const f32x4*)(xrow + 4 * lane + 256 * j); }
            else {
#pragma unroll
                for (int j = 0; j < 4; ++j) v[i][j] = (f32x4){0.f, 0.f, 0.f, 0.f}; } }
#pragma unroll
        for (int i = 0; i < RB; ++i) { const int r = r0 + i * NGW;
            if (r >= MTOK) break;
            const int grp = r < NCTX ? 0 : 1 + ((r - NCTX) >> 10);
            const float* sh = ada + grp * 6144 + (which ? 3072 : 0);
            const float* sc = sh + 1024;
            float ss = 0.f;
#pragma unroll
            for (int j = 0; j < 4; ++j) ss += (v[i][j].x * v[i][j].x + v[i][j].y * v[i][j].y) + (v[i][j].z * v[i][j].z + v[i][j].w * v[i][j].w);
            const float rstd = rsqrtf(wave_sum(ss) * (1.f / DM) + RMS_EPS);
#pragma unroll
            for (int j = 0; j < 4; ++j) {
                const int c = 4 * lane + 256 * j;
                const f32x4 gg = *(const f32x4*)(g + c), s1 = *(const f32x4*)(sc + c), s0 = *(const f32x4*)(sh + c);
                const f32x4 y = (v[i][j] * rstd * gg) * (s1 + 1.0f) + s0;
                u32x2 o; o.x = pk2(y.x, y.y); o.y = pk2(y.z, y.w);
                *(u32x2*)(H + (size_t)r * DM + c) = o;
            }
        }
    }
}
#define XB_TMO      128
#define XB_XCNT(j)  (256  + 64 * (j))
#define XB_XSUB(j)  (1280 + 64 * (j))
#define XB_XGEN(j)  (2304 + 64 * (j))
#define XB_TOP      3328
#define XB_TOPGEN   3392
#define XCD_BAR_WORDS 3456
#define XB_SPIN_CAP (1u << 18)

__device__ __forceinline__ unsigned xb_ld(unsigned* p)              { return __hip_atomic_load(p, __ATOMIC_RELAXED, __HIP_MEMORY_SCOPE_AGENT); }
__device__ __forceinline__ unsigned xb_add(unsigned* p, unsigned v) { return __hip_atomic_fetch_add(p, v, __ATOMIC_RELAXED, __HIP_MEMORY_SCOPE_AGENT); }
__device__ __forceinline__ unsigned xb_xcc_id() { return (unsigned)__builtin_amdgcn_s_getreg((3 << 11) | 20) & 0xFu; }
#define XB_SPIN(cond, bar) do { unsigned _sp = 0; while (cond) { __builtin_amdgcn_s_sleep(1); \
    if ((++_sp & 255u) == 0u) { if (xb_ld(&(bar)[XB_TMO])) break; if (_sp > XB_SPIN_CAP) { atomicAdd(&(bar)[XB_TMO], 1u); break; } } } } while (0)

struct XcdBarrier {
    unsigned* bar; unsigned x;
    volatile LAS unsigned* st;
};

__device__ __forceinline__ XcdBarrier xcd_barrier_post(unsigned* bar, volatile LAS unsigned* st) {
    XcdBarrier b; b.bar = bar; b.x = xb_xcc_id(); b.st = st;
    if (threadIdx.x == 0) (void)xb_add(&bar[XB_XCNT(b.x)], 1u);
    return b;
}
__device__ __forceinline__ void xcd_barrier_complete(unsigned* bar, unsigned x, unsigned& nloc, unsigned& nx) {
    const unsigned G = gridDim.x * gridDim.y * gridDim.z;
    unsigned sum, cnt, mine, sp = 0u;
    for (;;) {
        sum = 0u; cnt = 0u; mine = 0u;
#pragma unroll
        for (unsigned j = 0; j < 16; ++j) { const unsigned c = xb_ld(&bar[XB_XCNT(j)]); sum += c; cnt += (c > 0u) ? 1u : 0u; mine = (j == x) ? c : mine; }
        if (sum == G) break;
        __builtin_amdgcn_s_sleep(1);
        if ((++sp & 255u) == 0u) { if (xb_ld(&bar[XB_TMO])) break; if (sp > XB_SPIN_CAP) { atomicAdd(&bar[XB_TMO], 1u); break; } }
    }
    nloc = mine > 0u ? mine : 1u; nx = cnt > 0u ? cnt : 1u;
}

__device__ __forceinline__ void xcd_barrier(const XcdBarrier& b) {
    asm volatile("s_waitcnt vmcnt(0)" ::: "memory");
    __syncthreads();
    if (threadIdx.x == 0) {
        unsigned* bar = b.bar;
        __builtin_amdgcn_s_waitcnt(0);
        unsigned nloc = b.st[0], nx = b.st[1];
        if (nloc == 0u) { xcd_barrier_complete(bar, b.x, nloc, nx); b.st[0] = nloc; b.st[1] = nx; }
        const unsigned old = xb_add(&bar[XB_XSUB(b.x)], 1u);
        const unsigned gen = old / nloc;
        if (old + 1u == (gen + 1u) * nloc) {
            __builtin_amdgcn_fence(__ATOMIC_RELEASE, "agent");
            asm volatile("s_waitcnt vmcnt(0)" ::: "memory");
            const unsigned og = xb_add(&bar[XB_TOP], 1u);
            const unsigned tg = og / nx;
            if (og + 1u == (tg + 1u) * nx) xb_add(&bar[XB_TOPGEN], 1u);
            else XB_SPIN(xb_ld(&bar[XB_TOPGEN]) == tg, bar);
            __builtin_amdgcn_fence(__ATOMIC_ACQUIRE, "agent");
            xb_add(&bar[XB_XGEN(b.x)], 1u);
            asm volatile("s_waitcnt vmcnt(0)" ::: "memory");
        } else {
            XB_SPIN(xb_ld(&bar[XB_XGEN(b.x)]) == gen, bar);
            __builtin_amdgcn_fence(__ATOMIC_ACQUIRE, "agent");
            asm volatile("s_waitcnt vmcnt(0)" ::: "memory");
        }
    }
    __syncthreads();
}

typedef const pg8::f32x4 (&AccRef)[2][2][4][2];

struct EpiIn {
    static constexpr bool PERM = false, AFTER_DRAIN = false, HAS_MID = false; static constexpr int MID_T = 0;
    const Args* a; LAS unsigned char* lds;
    DI void operator()(AccRef acc, const pg8::Unit& u, int wr, int wc, int fr, int fq) const {
        asm volatile("" : "+v"(fr), "+v"(fq));
        unsigned char* ws = a->ws;
        const int pn = u.pn, pm = u.pm;
        const bool lat = pm >= 32;
        const int row0 = pm * 256 + wr * 64 + fr;
        if (pn >= 9) {
            u16* G = (u16*)(ws + WS_G);
#pragma unroll
            for (int ai = 0; ai < 2; ++ai)
#pragma unroll
                for (int m = 0; m < 4; ++m) { u16* rp = G + (size_t)(row0 + ai * 128 + m * 16) * G_P + (pn - 9) * 256 + wc * 64 + 4 * fq;
#pragma unroll
                    for (int bj = 0; bj < 2; ++bj)
#pragma unroll
                        for (int n = 0; n < 2; ++n) { const pg8::f32x4 v = acc[ai][bj][m][n]; u32x2 o; o.x = pk2(sigmoidf_(v[0]), sigmoidf_(v[1])); o.y = pk2(sigmoidf_(v[2]), sigmoidf_(v[3]));
                            *(u32x2*)(rp + 32 * bj + 16 * n) = o; } }
            return;
        }
        const bool isv = (pn == 2 && wc >= 2) || pn == 7 || pn == 8;
        if (isv) {
            int nh, hd; u16* vt; float* ov;
            if (pn == 2) { nh = 2; hd = wc - 2; vt = (u16*)(ws + (lat ? WS_VTA_LAT : WS_VTA_CTX)); ov = a->out + OUT_AV; }
            else { nh = 8; hd = (pn - 7) * 4 + wc; vt = (u16*)(ws + (lat ? WS_VTB_LAT : WS_VTB_CTX)); ov = a->out + OUT_BV; }
            const int Tsh = lat ? 10 : 8;
            const int bb = lat ? (pm - 32) >> 2 : pm;
            const unsigned tb = (unsigned)((lat ? ((pm - 32) & 3) * 256 : 0) + wr * 64);
            u16* vb = vt + (((size_t)(bb * nh + hd) * 64) << Tsh);
            LAS u16* sc = (LAS u16*)(lds + 131072 + (wr * 4 + wc) * 1024);
            const int lane = fr + 16 * fq, dd = lane >> 2, tg = lane & 3;
            int blk = 0;
#pragma unroll
            for (int ai = 0; ai < 2; ++ai)
#pragma unroll
                for (int m = 0; m < 4; ++m) {
#pragma unroll
                    for (int bj = 0; bj < 2; ++bj)
#pragma unroll
                        for (int n = 0; n < 2; ++n) { const pg8::f32x4 v = acc[ai][bj][m][n]; const unsigned d = 32 * bj + 16 * n + 4 * fq;
                            LAS u16* sb = sc + (blk & 1) * 256; ++blk;
                            u32x2 w; w.x = pk2(v[0], v[1]); w.y = pk2(v[2], v[3]);
                            *(LAS u32x2*)(sb + fr * 16 + 4 * fq) = w;
                            const unsigned e0 = sb[(4 * tg + 0) * 16 + dd], e1 = sb[(4 * tg + 1) * 16 + dd], e2 = sb[(4 * tg + 2) * 16 + dd], e3 = sb[(4 * tg + 3) * 16 + dd];
                            u32x2 o; o.x = e0 | (e1 << 16); o.y = e2 | (e3 << 16);
                            *(u32x2*)(vb + ((32 * bj + 16 * n + dd) << Tsh) + tb + ai * 128 + m * 16 + 4 * tg) = o;
                            if (!lat) *(pg8::f32x4*)(ov + (unsigned)(((row0 + ai * 128 + m * 16) * nh + hd) * 64) + d) = v; }
                    __builtin_amdgcn_sched_barrier(0); }
            return;
        }
        const float* nw; float* ok = nullptr; int nh = 0, hd = 0; bool rope = false;
        const float qscale = (pn < 2 || pn == 3 || pn == 4) ? 0.125f * 1.4426950408889634f : 1.0f;
        if (pn < 2) { nw = a->in[I_QNA]; rope = lat; }
        else if (pn == 2) { nw = a->in[I_KNA]; rope = lat; ok = a->out + OUT_AK; nh = 2; hd = wc; }
        else if (pn < 5) { nw = a->in[I_QNB]; }
        else { nw = a->in[I_KNB]; ok = a->out + OUT_BK; nh = 8; hd = (pn - 5) * 4 + wc; }
        u16* Q = (u16*)(ws + WS_QKV);
        pg8::f32x4 wv[2][2];
#pragma unroll
        for (int bj = 0; bj < 2; ++bj)
#pragma unroll
            for (int n = 0; n < 2; ++n) wv[bj][n] = *(const pg8::f32x4*)(nw + 32 * bj + 16 * n + 4 * fq);
        const float* rtab = (const float*)(ws + WS_ROPE) + fq * 8;
#pragma unroll
        for (int ai = 0; ai < 2; ++ai)
#pragma unroll
            for (int m = 0; m < 4; ++m) {
                const int r = row0 + ai * 128 + m * 16;
                pg8::f32x4 v[2][2]; float ss = 0.f;
#pragma unroll
                for (int bj = 0; bj < 2; ++bj)
#pragma unroll
                    for (int n = 0; n < 2; ++n) { v[bj][n] = acc[ai][bj][m][n]; ss += (v[bj][n][0] * v[bj][n][0] + v[bj][n][1] * v[bj][n][1]) + (v[bj][n][2] * v[bj][n][2] + v[bj][n][3] * v[bj][n][3]); }
                ss += __shfl_xor(ss, 16); ss += __shfl_xor(ss, 32);
                const float rs = rsqrtf(ss * (1.f / 64.f) + RMS_EPS) * qscale;
#pragma unroll
                for (int bj = 0; bj < 2; ++bj)
#pragma unroll
                    for (int n = 0; n < 2; ++n) v[bj][n] = v[bj][n] * rs * wv[bj][n];
                if (rope) {
                    const int t = (r - NCTX) & 1023;
#pragma unroll
                    for (int bj = 0; bj < 2; ++bj) { const int pos = (bj == 0 ? (t >> 6) : (t & 63));
                        const pg8::f32x4 cs = *(const pg8::f32x4*)(rtab + pos * 32), sn = *(const pg8::f32x4*)(rtab + pos * 32 + 4);
                        const pg8::f32x4 x1 = v[bj][0], x2 = v[bj][1]; v[bj][0] = x1 * cs - x2 * sn; v[bj][1] = x2 * cs + x1 * sn; }
                }
                u16* rp = Q + (size_t)r * QKV_P + pn * 256 + wc * 64 + 4 * fq;
#pragma unroll
                for (int bj = 0; bj < 2; ++bj)
#pragma unroll
                    for (int n = 0; n < 2; ++n) { u32x2 o; o.x = pk2(v[bj][n][0], v[bj][n][1]); o.y = pk2(v[bj][n][2], v[bj][n][3]); *(u32x2*)(rp + 32 * bj + 16 * n) = o;
                        if (ok && !lat) *(pg8::f32x4*)(ok + ((size_t)r * nh + hd) * 64 + 32 * bj + 16 * n + 4 * fq) = v[bj][n]; }
                __builtin_amdgcn_sched_barrier(0);
            }
    }
};

struct EpiGate {
    static constexpr bool PERM = false, AFTER_DRAIN = false, HAS_MID = true; static constexpr int MID_T = 8;
    const Args* a;
    static DI pg8::f32x4 unpack4(u32x2 g) { pg8::f32x4 v; v[0] = __uint_as_float(g.x << 16); v[1] = __uint_as_float(g.x & 0xffff0000u); v[2] = __uint_as_float(g.y << 16); v[3] = __uint_as_float(g.y & 0xffff0000u); return v; }
    static DI pg8::f32x4 floor4(pg8::f32x4 v) { v[0] = fmaxf(v[0], 1e-30f); v[1] = fmaxf(v[1], 1e-30f); v[2] = fmaxf(v[2], 1e-30f); v[3] = fmaxf(v[3], 1e-30f); return v; }
    DI void mid(pg8::f32x4 (&acc)[2][2][4][2], const pg8::Unit& u, int wr, int wc, int fr, int fq) const {
        asm volatile("" : "+v"(fr), "+v"(fq));
        const u16* G = (const u16*)(a->ws + WS_G);
        const int row0 = u.pm * 256 + wr * 64 + fr, col0 = u.pn * 256 + wc * 32 + 4 * fq;
#pragma unroll
        for (int ai = 0; ai < 2; ++ai)
#pragma unroll
            for (int m = 0; m < 4; ++m) { const size_t r = row0 + ai * 128 + m * 16;
#pragma unroll
                for (int bj = 0; bj < 2; ++bj)
#pragma unroll
                    for (int n = 0; n < 2; ++n) { const int c = col0 + 128 * bj + 16 * n;
                        const pg8::f32x4 sa = unpack4(*(const u32x2*)(G + r * G_P + c)), sb = floor4(unpack4(*(const u32x2*)(G + r * G_P + 1024 + c)));
                        pg8::f32x4 q; q[0] = sa[0] * __builtin_amdgcn_rcpf(sb[0]); q[1] = sa[1] * __builtin_amdgcn_rcpf(sb[1]); q[2] = sa[2] * __builtin_amdgcn_rcpf(sb[2]); q[3] = sa[3] * __builtin_amdgcn_rcpf(sb[3]);
                        acc[ai][bj][m][n] *= q; } }
    }
    DI void mid128(pg8::f32x4 (&acc)[4][2], int pm, int pn, int wr, int wc, int fr, int fq) const {
        asm volatile("" : "+v"(fr), "+v"(fq));
        const u16* G = (const u16*)(a->ws + WS_G);
        const int row0 = pm * 128 + wr * 64 + fr, col0 = pn * 128 + wc * 32 + 4 * fq;
#pragma unroll
        for (int m = 0; m < 4; ++m) { const size_t r = row0 + m * 16;
#pragma unroll
            for (int n = 0; n < 2; ++n) { const int c = col0 + 16 * n;
                const pg8::f32x4 sa = unpack4(*(const u32x2*)(G + r * G_P + c)), sb = floor4(unpack4(*(const u32x2*)(G + r * G_P + 1024 + c)));
                pg8::f32x4 q; q[0] = sa[0] * __builtin_amdgcn_rcpf(sb[0]); q[1] = sa[1] * __builtin_amdgcn_rcpf(sb[1]); q[2] = sa[2] * __builtin_amdgcn_rcpf(sb[2]); q[3] = sa[3] * __builtin_amdgcn_rcpf(sb[3]);
                acc[m][n] *= q; } }
    }
    DI void epi128(const pg8::f32x4 (&acc)[4][2], int pm, int pn, int wr, int wc, int fr, int fq) const {
        asm volatile("" : "+v"(fr), "+v"(fq));
        const u16* G = (const u16*)(a->ws + WS_G) + 1024; u16* T = (u16*)(a->ws + WS_T);
        const int row0 = pm * 128 + wr * 64 + fr, col0 = pn * 128 + wc * 32 + 4 * fq;
#pragma unroll
        for (int m = 0; m < 4; ++m) { const size_t r = row0 + m * 16;
#pragma unroll
            for (int n = 0; n < 2; ++n) { const int c = col0 + 16 * n;
                const pg8::f32x4 v = acc[m][n] * floor4(unpack4(*(const u32x2*)(G + r * G_P + c)));
                u32x2 o; o.x = pk2(v[0], v[1]); o.y = pk2(v[2], v[3]); *(u32x2*)(T + r * DM + c) = o; } }
    }
    DI void operator()(AccRef acc, const pg8::Unit& u, int wr, int wc, int fr, int fq) const {
        asm volatile("" : "+v"(fr), "+v"(fq));
        const u16* G = (const u16*)(a->ws + WS_G) + 1024; u16* T = (u16*)(a->ws + WS_T);
        const int row0 = u.pm * 256 + wr * 64 + fr, col0 = u.pn * 256 + wc * 32 + 4 * fq;
#pragma unroll
        for (int ai = 0; ai < 2; ++ai)
#pragma unroll
            for (int m = 0; m < 4; ++m) { const size_t r = row0 + ai * 128 + m * 16;
#pragma unroll
                for (int bj = 0; bj < 2; ++bj)
#pragma unroll
                    for (int n = 0; n < 2; ++n) { const int c = col0 + 128 * bj + 16 * n;
                        const pg8::f32x4 v = acc[ai][bj][m][n] * floor4(unpack4(*(const u32x2*)(G + r * G_P + c)));
                        u32x2 o; o.x = pk2(v[0], v[1]); o.y = pk2(v[2], v[3]); *(u32x2*)(T + r * DM + c) = o; } }
    }
};

template <int FINAL> struct EpiRes {
    static constexpr bool PERM = false, AFTER_DRAIN = false, HAS_MID = false; static constexpr int MID_T = 0;
    const Args* a;
    DI void operator()(AccRef acc, const pg8::Unit& u, int wr, int wc, int fr, int fq) const {
        asm volatile("" : "+v"(fr), "+v"(fq));
        const int pm = u.pm; const int grp = pm < 32 ? 0 : 1 + ((pm - 32) >> 2);
        const float* gate = (const float*)(a->ws + WS_CTL) + grp * 6144 + (FINAL ? 5120 : 2048);
        float* out = FINAL ? a->out + OUT_Y : (float*)(a->ws + WS_TMP);
        const float* base = FINAL ? (const float*)(a->ws + WS_TMP) : (pm < 32 ? a->in[I_XP] : a->in[I_XS] - (size_t)NCTX * DM);
        const int row0 = pm * 256 + wr * 64 + fr, col0 = u.pn * 256 + wc * 32 + 4 * fq;
        pg8::f32x4 gv[2][2];
#pragma unroll
        for (int bj = 0; bj < 2; ++bj)
#pragma unroll
            for (int n = 0; n < 2; ++n) gv[bj][n] = *(const pg8::f32x4*)(gate + col0 + 128 * bj + 16 * n);
#pragma unroll
        for (int ai = 0; ai < 2; ++ai)
#pragma unroll
            for (int m = 0; m < 4; ++m) { const size_t r = row0 + ai * 128 + m * 16;
#pragma unroll
                for (int bj = 0; bj < 2; ++bj)
#pragma unroll
                    for (int n = 0; n < 2; ++n) { const int c = col0 + 128 * bj + 16 * n;
                        const pg8::f32x4 b = *(const pg8::f32x4*)(base + r * DM + c);
                        *(pg8::f32x4*)(out + r * DM + c) = b + gv[bj][n] * acc[ai][bj][m][n]; } }
    }
};

struct EpiResNorm {
    static constexpr bool PERM = false, AFTER_DRAIN = true, HAS_MID = false; static constexpr int MID_T = 0;
    const Args* a;
    DI void operator()(AccRef, const pg8::Unit&, int, int, int, int) const {}
    DI void fused(pg8::f32x4 (&acc)[2][2][4][2], const pg8::Unit& u, int wr, int wc, int fr, int fq, LAS unsigned char* lds, int wid, int lane) const {
        LAS float* P = (LAS float*)lds;
        LAS float* S = (LAS float*)(lds + 4096);
        const int pm = u.pm, grp = pm < 32 ? 0 : 1 + ((pm - 32) >> 2);
        const float* adag = (const float*)(a->ws + WS_CTL) + grp * 6144;
        float* TMP = (float*)(a->ws + WS_TMP);
        const float* base = pm < 32 ? a->in[I_XP] : a->in[I_XS] - (size_t)NCTX * DM;
        const int row0 = pm * 256 + wr * 64 + fr, col0 = u.pn * 256 + wc * 32 + 4 * fq;
        {
            pg8::f32x4 gv[2][2];
#pragma unroll
            for (int bj = 0; bj < 2; ++bj)
#pragma unroll
                for (int n = 0; n < 2; ++n) gv[bj][n] = *(const pg8::f32x4*)(adag + 2048 + col0 + 128 * bj + 16 * n);
#pragma unroll
            for (int ai = 0; ai < 2; ++ai)
#pragma unroll
                for (int m = 0; m < 4; ++m) { const size_t r = row0 + ai * 128 + m * 16; float ss = 0.f;
#pragma unroll
                    for (int bj = 0; bj < 2; ++bj)
#pragma unroll
                        for (int n = 0; n < 2; ++n) { const int c = col0 + 128 * bj + 16 * n;
                            const pg8::f32x4 x1 = *(const pg8::f32x4*)(base + r * DM + c) + gv[bj][n] * acc[ai][bj][m][n];
                            acc[ai][bj][m][n] = x1; *(pg8::f32x4*)(TMP + r * DM + c) = x1;
                            ss += (x1[0] * x1[0] + x1[1] * x1[1]) + (x1[2] * x1[2] + x1[3] * x1[3]); }
                    ss += __shfl_xor(ss, 16); ss += __shfl_xor(ss, 32);
                    if (fq == 0) P[(ai * 128 + wr * 64 + m * 16 + fr) * 4 + wc] = ss; }
        }
        asm volatile("s_waitcnt lgkmcnt(0)" ::: "memory"); __builtin_amdgcn_s_barrier(); asm volatile("" ::: "memory");
        float* slots = (float*)(a->ws + WS_RSS); unsigned* cnt = (unsigned*)(a->ws + WS_CTL + CTL_PANEL) + 64 * pm;
        const int row = wid * 32 + (lane & 31);
        if (lane < 32) { const float t = (P[row * 4 + 0] + P[row * 4 + 1]) + (P[row * 4 + 2] + P[row * 4 + 3]);
            __hip_atomic_store(slots + ((size_t)(pm * 256 + row) * 4 + u.pn), t, __ATOMIC_RELAXED, __HIP_MEMORY_SCOPE_AGENT); }
        asm volatile("s_waitcnt vmcnt(0)" ::: "memory");
        if (lane == 0) __hip_atomic_fetch_add(cnt, 1u, __ATOMIC_RELAXED, __HIP_MEMORY_SCOPE_AGENT);
        if (wid == 0) { unsigned sp = 0;
            while ((unsigned)__builtin_amdgcn_readfirstlane(__hip_atomic_load(cnt, __ATOMIC_RELAXED, __HIP_MEMORY_SCOPE_AGENT)) < 32u && ++sp < (1u << 20)) __builtin_amdgcn_s_sleep(2);
            __builtin_amdgcn_fence(__ATOMIC_ACQUIRE, "agent"); }
        asm volatile("s_waitcnt vmcnt(0) lgkmcnt(0)" ::: "memory"); __builtin_amdgcn_s_barrier(); asm volatile("" ::: "memory");
        if (lane < 32) { const float* sl = slots + (size_t)(pm * 256 + row) * 4; float t = 0.f;
#pragma unroll
            for (int q = 0; q < 4; ++q) t += __hip_atomic_load(sl + q, __ATOMIC_RELAXED, __HIP_MEMORY_SCOPE_AGENT);
            S[row] = rsqrtf(t * (1.f / DM) + RMS_EPS); }
        asm volatile("s_waitcnt lgkmcnt(0)" ::: "memory"); __builtin_amdgcn_s_barrier(); asm volatile("" ::: "memory");
        u16* H = (u16*)(a->ws + WS_H);
        pg8::f32x4 gm[2][2], sh[2][2];
#pragma unroll
        for (int bj = 0; bj < 2; ++bj)
#pragma unroll
            for (int n = 0; n < 2; ++n) { const int c = col0 + 128 * bj + 16 * n; gm[bj][n] = *(const pg8::f32x4*)(a->in[I_GFFN] + c) * (*(const pg8::f32x4*)(adag + 4096 + c) + 1.0f); sh[bj][n] = *(const pg8::f32x4*)(adag + 3072 + c); }
#pragma unroll
        for (int ai = 0; ai < 2; ++ai)
#pragma unroll
            for (int m = 0; m < 4; ++m) { const size_t r = row0 + ai * 128 + m * 16; const float rstd = S[ai * 128 + wr * 64 + m * 16 + fr];
#pragma unroll
                for (int bj = 0; bj < 2; ++bj)
#pragma unroll
                    for (int n = 0; n < 2; ++n) { const pg8::f32x4 y = (acc[ai][bj][m][n] * rstd) * gm[bj][n] + sh[bj][n];
                        u32x2 o; o.x = pk2(y[0], y[1]); o.y = pk2(y[2], y[3]); *(u32x2*)(H + r * DM + col0 + 128 * bj + 16 * n) = o; } }
    }
};

struct EpiSwiglu {
    static constexpr bool PERM = false, AFTER_DRAIN = false, HAS_MID = false; static constexpr int MID_T = 0;
    const Args* a;
    DI void operator()(AccRef acc, const pg8::Unit& u, int wr, int wc, int fr, int fq) const {
        asm volatile("" : "+v"(fr), "+v"(fq));
        u16* GU = (u16*)(a->ws + WS_GU);
        const int row0 = u.pm * 256 + wr * 64 + fr, col0 = u.pn * 128 + wc * 16 + 4 * fq;
#pragma unroll
        for (int ai = 0; ai < 2; ++ai)
#pragma unroll
            for (int m = 0; m < 4; ++m) { const size_t r = row0 + ai * 128 + m * 16;
#pragma unroll
                for (int bj = 0; bj < 2; ++bj) { const pg8::f32x4 g = acc[ai][bj][m][0], up = acc[ai][bj][m][1];
                    u32x2 o; o.x = pk2(siluf_(g[0]) * up[0], siluf_(g[1]) * up[1]); o.y = pk2(siluf_(g[2]) * up[2], siluf_(g[3]) * up[3]);
                    *(u32x2*)(GU + r * DFF + col0 + 64 * bj) = o; } }
    }
};
template <class Epi>
DI void gemm128_phase(LAS unsigned char* lds, const pg8::Gemm g, const Epi& E) {
    int tid_ = threadIdx.x; asm volatile("" : "+v"(tid_));
    const int tid = tid_, wid = __builtin_amdgcn_readfirstlane(tid >> 6), lane = tid & 63, wr = wid >> 2, wc = wid & 3, fr = lane & 15, fq = lane >> 4;
    const int K = g.K, nt = K / 64, nN = g.N / 128, nun = (g.M / 128) * nN;
    unsigned voff[2];
#pragma unroll
    for (int i = 0; i < 2; ++i) { int R, C; pg8::stage_rc(tid * 16 + i * 8192, R, C); voff[i] = (unsigned)(R * K + C) * 2u; }
    const unsigned ldsw = (unsigned)wid * 1024u;
    const int aoff = pg8::lds_byte(wr * 64 + fr, fq * 8), boff = pg8::lds_byte(wc * 32 + fr, fq * 8);
#define G128_STAGE(buf, kt) do { const char* ga_ = cA + (size_t)(kt) * 128; const char* gb_ = cB + (size_t)(kt) * 128; _Pragma("unroll") for (int _i = 0; _i < 2; ++_i) { \
        __builtin_amdgcn_global_load_lds((const unsigned*)(ga_ + voff[_i]), (LAS unsigned*)(lds + (buf) * 32768 + ldsw + _i * 8192), 16, 0, 0); \
        __builtin_amdgcn_global_load_lds((const unsigned*)(gb_ + voff[_i]), (LAS unsigned*)(lds + (buf) * 32768 + 16384 + ldsw + _i * 8192), 16, 0, 0); } } while (0)
    for (int u = blockIdx.x; u < nun; u += gridDim.x) {
        const int pm = u / nN, pn = u % nN;
        const char* cA = (const char*)g.A + (size_t)pm * 128 * K * 2; const char* cB = (const char*)g.Bt + (size_t)pn * 128 * K * 2;
        pg8::f32x4 acc[4][2];
#pragma unroll
        for (int m = 0; m < 4; ++m)
#pragma unroll
            for (int n = 0; n < 2; ++n) acc[m][n] = (pg8::f32x4){0.f, 0.f, 0.f, 0.f};
        G128_STAGE(0, 0); G128_STAGE(1, 1);
        int buf = 0;
        for (int t = 0; t < nt; ++t) {
            if (t + 1 < nt) asm volatile("s_waitcnt vmcnt(4)" ::: "memory"); else asm volatile("s_waitcnt vmcnt(0)" ::: "memory");
            __builtin_amdgcn_s_barrier(); __builtin_amdgcn_sched_barrier(0);
            if (t + 2 < nt) { const int nb = buf == 0 ? 2 : buf - 1; G128_STAGE(nb, t + 2); }
            if constexpr (Epi::HAS_MID) { if (t == Epi::MID_T) E.mid128(acc, pm, pn, wr, wc, fr, fq); }
            pg8::bf16x8 At[4][2], Bf[2][2];
#pragma unroll
            for (int n = 0; n < 2; ++n)
#pragma unroll
                for (int k = 0; k < 2; ++k) Bf[n][k] = *(const LAS pg8::bf16x8*)(lds + buf * 32768 + 16384 + boff + n * 2048 + k * 1024);
#pragma unroll
            for (int m = 0; m < 4; ++m)
#pragma unroll
                for (int k = 0; k < 2; ++k) At[m][k] = *(const LAS pg8::bf16x8*)(lds + buf * 32768 + aoff + m * 2048 + k * 1024);
            asm volatile("s_waitcnt lgkmcnt(0)" ::: "memory"); __builtin_amdgcn_sched_barrier(0);
            __builtin_amdgcn_s_setprio(1);
#pragma unroll
            for (int m = 0; m < 4; ++m)
#pragma unroll
                for (int n = 0; n < 2; ++n)
#pragma unroll
                    for (int k = 0; k < 2; ++k) acc[m][n] = __builtin_amdgcn_mfma_f32_16x16x32_bf16(Bf[n][k], At[m][k], acc[m][n], 0, 0, 0);
            __builtin_amdgcn_s_setprio(0);
            buf = buf == 2 ? 0 : buf + 1;
        }
        E.epi128(acc, pm, pn, wr, wc, fr, fq);
        __builtin_amdgcn_s_barrier(); __builtin_amdgcn_sched_barrier(0);
    }
#undef G128_STAGE
}
#define MFMA32(a, b, c) __builtin_amdgcn_mfma_f32_32x32x16_bf16((a), (b), (c), 0, 0, 0)
struct AState { float m, l; f32x16 o0, o1; };
struct AMask { int dq; int e0; const LAS float* bp; bool rowok; };
struct KVFrag { bf16x8 k[4]; bf16x8 v[4]; };
DI int koff_(int i, int h) { return (i & 7) + 16 * (i >> 3) + 8 * h; }

DI void attn_load(KVFrag& f, const u16* kp, const u16* vp, size_t v32) {
#pragma unroll
    for (int t = 0; t < 4; ++t) f.k[t] = *(const bf16x8*)(kp + 16 * t);
#pragma unroll
    for (int dt = 0; dt < 2; ++dt)
#pragma unroll
        for (int sI = 0; sI < 2; ++sI) f.v[dt * 2 + sI] = *(const bf16x8*)(vp + dt * v32 + 16 * sI);
}

template <int MODE>
DI void attn_compute(AState& st, const bf16x8 (&qf)[4], const KVFrag& f, int h, const AMask& mk) {
    f32x16 s;
#pragma unroll
    for (int i = 0; i < 16; ++i) s[i] = 0.f;
#pragma unroll
    for (int t = 0; t < 4; ++t) s = MFMA32(f.k[t], qf[t], s);
    float tmax = -1e30f;
#pragma unroll
    for (int i = 0; i < 16; ++i) {
        float v = s[i]; const int c = koff_(i, h);
        if (MODE == 1) { const int d = mk.dq - c; v = (d <= 128 && d >= -128) ? v : -INFINITY; }
        if (MODE == 2) { const bool ok = mk.rowok && (unsigned)(mk.e0 + c) < 16u; const float b = mk.bp[ok ? c : -mk.e0]; v = ok ? v + b : -INFINITY; }
        s[i] = v; tmax = fmaxf(tmax, v);
    }
    tmax = fmaxf(tmax, __shfl_xor(tmax, 32));
    const float mnew = fmaxf(st.m, tmax);
    const bool grew = __builtin_amdgcn_ballot_w64(mnew > st.m) != 0ull;
    const float alpha = grew ? __builtin_amdgcn_exp2f(st.m - mnew) : 1.0f;
    st.m = mnew;
    float psum = 0.f;
#pragma unroll
    for (int i = 0; i < 16; ++i) { const float p = __builtin_amdgcn_exp2f(s[i] - mnew); s[i] = p; psum += p; }
    if (grew) { st.l *= alpha;
#pragma unroll
        for (int i = 0; i < 16; ++i) { st.o0[i] *= alpha; st.o1[i] *= alpha; } }
    st.l += psum;
#pragma unroll
    for (int sI = 0; sI < 2; ++sI) {
        u32x4 pw; pw.x = pk2(s[8 * sI], s[8 * sI + 1]); pw.y = pk2(s[8 * sI + 2], s[8 * sI + 3]); pw.z = pk2(s[8 * sI + 4], s[8 * sI + 5]); pw.w = pk2(s[8 * sI + 6], s[8 * sI + 7]);
        const bf16x8 pb = __builtin_bit_cast(bf16x8, pw);
        st.o0 = MFMA32(f.v[sI], pb, st.o0);
        st.o1 = MFMA32(f.v[2 + sI], pb, st.o1);
    }
}

struct ASeg { const u16* kp; size_t kstep; const u16* vp; size_t v32; int n; int vstep; };
template <int KIND>
DI void attn_run(AState& st, const bf16x8 (&qf)[4], const ASeg& L, const ASeg& C, int h, int r, int w0, int w1, int w2, const LAS float* rpb_l) {
    const int nL = L.n, n = nL;
    KVFrag fa, fb;
#define A_LOAD(F, t) do { const int t_ = (t); attn_load(F, L.kp + t_ * L.kstep, L.vp + L.vstep * t_, L.v32); } while (0)
#define A_COMP(F, t) do { const int t_ = (t); AMask mk; mk.dq = 0; mk.e0 = 0; mk.bp = rpb_l; mk.rowok = true; \
        if (KIND && t_ < nL) { \
            if (KIND == 1) { mk.dq = (w0 - t_) * 32 + r;   if (w0 - t_ != 4 && w0 - t_ != -4) { attn_compute<0>(st, qf, F, h, mk); break; }   } \
            if (KIND == 2) { mk.e0 = w1;   mk.rowok = (unsigned)(t_ - w2) < 8u;   mk.bp = rpb_l + w0 + t_ * 31;   } \
            attn_compute<KIND>(st, qf, F, h, mk); \
        } else attn_compute<0>(st, qf, F, h, mk); } while (0)
    A_LOAD(fa, 0);
    for (int t = 0; t < n; t += 2) {
        if (t + 1 < n) A_LOAD(fb, t + 1);
        A_COMP(fa, t);
        if (t + 1 < n) { if (t + 2 < n) A_LOAD(fa, t + 2); A_COMP(fb, t + 1); }
    }
#undef A_LOAD
#undef A_COMP
}

DI void attn_lds_ctx(AState& st, const bf16x8 (&qf)[4], const LAS unsigned char* kl, const LAS unsigned char* vl, int pr, int r, int h, const LAS float* rpb_l) {
    const LAS unsigned char* kp_l = kl + pr * 144 + 16 * h; const LAS unsigned char* vp_l = vl + r * 528 + 16 * h;
    AMask mk; mk.dq = 0; mk.e0 = 0; mk.bp = rpb_l; mk.rowok = true;
#define LDS_FRAGS(F, kt_) do { _Pragma("unroll") for (int t = 0; t < 4; ++t) F.k[t] = *(const LAS bf16x8*)(kp_l + (kt_) * 32 * 144 + 32 * t); \
        _Pragma("unroll") for (int dt = 0; dt < 2; ++dt) _Pragma("unroll") for (int sI = 0; sI < 2; ++sI) F.v[dt * 2 + sI] = *(const LAS bf16x8*)(vp_l + dt * 32 * 528 + (kt_) * 64 + 32 * sI); } while (0)
    KVFrag f0, f1;
    LDS_FRAGS(f0, 0);
#pragma unroll 1
    for (int kt = 0; kt < 8; kt += 2) {
        LDS_FRAGS(f1, kt + 1);
        attn_compute<0>(st, qf, f0, h, mk);
        if (kt + 2 < 8) LDS_FRAGS(f0, kt + 2);
        attn_compute<0>(st, qf, f1, h, mk);
    }
#undef LDS_FRAGS
}

#ifndef LAT_GRP
#define LAT_GRP 8
#endif
#ifndef ATT_REV
#define ATT_REV 0
#endif
constexpr int N_ITEMS_LB = 512, N_ITEMS_LA = 512, N_ITEMS_CTX = 4096, N_ITEMS = N_ITEMS_LB + N_ITEMS_LA + N_ITEMS_CTX;

DI void attn_phase(const Args& a, int qi, LAS unsigned char* lds) {
    int tid_ = threadIdx.x; asm volatile("" : "+v"(tid_));
    unsigned char* ws = a.ws;
    unsigned* queue = (unsigned*)(ws + WS_CTL + CTL_QUEUE) + 64 * qi;
    const u16* QKV = (const u16*)(ws + WS_QKV);
    LAS float* rpb_l = (LAS float*)lds;
    for (int i = tid_; i < 8 * 15 * 31; i += 512) rpb_l[i] = a.in[I_RPB][i] * 1.4426950408889634f;
    __syncthreads();
    volatile LAS unsigned* qslot = (volatile LAS unsigned*)(lds + 16384);
    const int wave = __builtin_amdgcn_readfirstlane(tid_ >> 6);
    unsigned nextq = 0;
    if (tid_ == 0) nextq = atomicAdd(queue, 1u);
    for (;;) {
        __syncthreads();
        if (tid_ == 0) *qslot = nextq;
        __syncthreads();
        const int grp = __builtin_amdgcn_readfirstlane(*qslot);
        constexpr int N_LAT_GROUPS = (N_ITEMS_LB + N_ITEMS_LA) / LAT_GRP, N_GROUPS = N_LAT_GROUPS + N_ITEMS_CTX / 8;
        if (grp >= N_GROUPS) break;
        if (tid_ == 0) nextq = atomicAdd(queue, 1u);
        const bool latg = grp < N_LAT_GROUPS;
        const int base = latg ? grp * LAT_GRP : N_ITEMS_LB + N_ITEMS_LA + (grp - N_LAT_GROUPS) * 8;
        LAS unsigned char* kl = lds + 32768; LAS unsigned char* vl = lds + 32768 + 256 * 144;
        { const u16* ksrc; const u16* vsrc; int kpitch;
          if (latg) { if (base < N_ITEMS_LB) { const int b = base >> 8, hd = (base >> 5) & 7; ksrc = (const u16*)(ws + WS_CKB) + (size_t)b * 256 * 512 + 64 * hd; kpitch = 512; vsrc = (const u16*)(ws + WS_VCB) + (size_t)(b * 8 + hd) * 64 * 256; }
                      else { const int i2 = base - N_ITEMS_LB, b = i2 >> 8, kvh = ((i2 >> 5) & 7) >> 2; ksrc = (const u16*)(ws + WS_CKA) + (size_t)b * 256 * 128 + 64 * kvh; kpitch = 128; vsrc = (const u16*)(ws + WS_VCA) + (size_t)(b * 2 + kvh) * 64 * 256; } }
          else { const int i3 = base - N_ITEMS_LB - N_ITEMS_LA, b = i3 >> 7, hh = (i3 >> 3) & 15; const int hd = hh < 8 ? hh : hh - 8, kvh = hd >> 2; kpitch = QKV_P;
                 ksrc = QKV + (size_t)b * 256 * QKV_P + (hh < 8 ? 512 + 64 * kvh : 1280 + 64 * hd);
                 vsrc = hh < 8 ? (const u16*)(ws + WS_VTA_CTX) + (size_t)(b * 2 + kvh) * 64 * 256 : (const u16*)(ws + WS_VTB_CTX) + (size_t)(b * 8 + hd) * 64 * 256; }
#pragma unroll
          for (int i = 0; i < 4; ++i) { const int idx = tid_ + 512 * i;
              const u32x4 kv = *(const u32x4*)(ksrc + (size_t)(idx >> 3) * kpitch + 8 * (idx & 7));
              const u32x4 vv = *(const u32x4*)(vsrc + (size_t)(idx >> 5) * 256 + 8 * (idx & 31));
              *(LAS u32x4*)(kl + (idx >> 3) * 144 + 16 * (idx & 7)) = kv;
              *(LAS u32x4*)(vl + (idx >> 5) * 528 + 16 * (idx & 31)) = vv; }
        }
        __syncthreads();
        if (latg && wave >= LAT_GRP) continue;
        const int it = base + wave;
        int lane_ = tid_ & 63; asm volatile("" : "+v"(lane_));
        const int r = lane_ & 31, h = lane_ >> 5, pr = (r & 19) | ((r & 4) << 1) | ((r & 8) >> 1);
        AState st;
#pragma unroll
        for (int i = 0; i < 16; ++i) { st.o0[i] = 0.f; st.o1[i] = 0.f; }
        st.m = -1e30f; st.l = 0.f;
        bf16x8 qf[4];
        u16* outp;
        if (it < N_ITEMS_LB) {
            const int b = it >> 8, hd = (it >> 5) & 7, qt = it & 31, rq0 = (qt >> 2) * 2, c0 = (qt & 3) * 16;
            const int rq = rq0 + (r >> 4), cq = c0 + (r & 15);
            const size_t tok0 = (size_t)NCTX + b * 1024;
            const u16* qp = QKV + (tok0 + rq * 64 + cq) * QKV_P + 768 + 64 * hd + 8 * h;
#pragma unroll
            for (int t = 0; t < 4; ++t) qf[t] = *(const bf16x8*)(qp + 16 * t);
            const int cs = min(max(cq - 8, 0), 48), rs = min(max(rq - 4, 0), 8);
            const int kr0 = min(max(rq0 - 4, 0), 8), kr1 = min(max(rq0 + 1 - 4, 0), 8) + 7;
            const int wst = min(max(c0 - 8, 0), 32);
            ASeg L, C;
            L.kp = QKV + (tok0 + kr0 * 64 + wst + pr) * QKV_P + 1280 + 64 * hd + 8 * h; L.kstep = (size_t)64 * QKV_P;
            L.vp = (const u16*)(ws + WS_VTB_LAT) + ((size_t)(b * 8 + hd) * 64 + r) * 1024 + kr0 * 64 + wst + 8 * h; L.v32 = (size_t)32 * 1024; L.n = kr1 - kr0 + 1; L.vstep = 64;
            C.kp = (const u16*)(ws + WS_CKB) + ((size_t)b * 256 + pr) * 512 + 64 * hd + 8 * h; C.kstep = (size_t)32 * 512;
            C.vp = (const u16*)(ws + WS_VCB) + ((size_t)(b * 8 + hd) * 64 + r) * 256 + 8 * h; C.v32 = (size_t)32 * 256; C.n = 0; C.vstep = 32;
            attn_run<2>(st, qf, L, C, h, r, (hd * 15 + kr0 - rq + 7) * 31 + (wst - cq + 15), wst - cs, rs - kr0, rpb_l);
            attn_lds_ctx(st, qf, kl, vl, pr, r, h, rpb_l);
            outp = (u16*)(ws + WS_YA) + (tok0 + rq * 64 + cq) * 1024 + 512 + 64 * hd;
        } else if (it < N_ITEMS_LB + N_ITEMS_LA) {
            const int i2 = it - N_ITEMS_LB, b = i2 >> 8, hd = (i2 >> 5) & 7, qt = i2 & 31, kvh = hd >> 2;
            const size_t tok0 = (size_t)NCTX + b * 1024;
            const u16* qp = QKV + (tok0 + qt * 32 + r) * QKV_P + 64 * hd + 8 * h;
#pragma unroll
            for (int t = 0; t < 4; ++t) qf[t] = *(const bf16x8*)(qp + 16 * t);
            st.m = a.in[I_SINK][hd] * 1.4426950408889634f; st.l = h == 0 ? 1.f : 0.f;
            const int k_lo = max(qt - 4, 0), k_hi = min(qt + 4, 31);
            ASeg L, C;
            L.kp = QKV + (tok0 + k_lo * 32 + pr) * QKV_P + 512 + 64 * kvh + 8 * h; L.kstep = (size_t)32 * QKV_P;
            L.vp = (const u16*)(ws + WS_VTA_LAT) + ((size_t)(b * 2 + kvh) * 64 + r) * 1024 + k_lo * 32 + 8 * h; L.v32 = (size_t)32 * 1024; L.n = k_hi - k_lo + 1; L.vstep = 32;
            C.kp = (const u16*)(ws + WS_CKA) + ((size_t)b * 256 + pr) * 128 + 64 * kvh + 8 * h; C.kstep = (size_t)32 * 128;
            C.vp = (const u16*)(ws + WS_VCA) + ((size_t)(b * 2 + kvh) * 64 + r) * 256 + 8 * h; C.v32 = (size_t)32 * 256; C.n = 0; C.vstep = 32;
            attn_run<1>(st, qf, L, C, h, r, qt - k_lo, 0, 0, rpb_l);
            attn_lds_ctx(st, qf, kl, vl, pr, r, h, rpb_l);
            outp = (u16*)(ws + WS_YA) + (tok0 + qt * 32 + r) * 1024 + 64 * hd;
        } else {
            const int i3 = base - N_ITEMS_LB - N_ITEMS_LA, b = i3 >> 7, hh = (i3 >> 3) & 15, qt = wave;
            const size_t tok0 = (size_t)b * 256;
            const int hd = hh < 8 ? hh : hh - 8, kvh = hd >> 2;
            const u16* qp = QKV + (tok0 + qt * 32 + r) * QKV_P + (hh < 8 ? 64 * hd : 768 + 64 * hd) + 8 * h;
#pragma unroll
            for (int t = 0; t < 4; ++t) qf[t] = *(const bf16x8*)(qp + 16 * t);
            if (hh < 8) { st.m = a.in[I_SINK][hd] * 1.4426950408889634f; st.l = h == 0 ? 1.f : 0.f; }
            outp = (u16*)(ws + WS_YA) + (tok0 + qt * 32 + r) * 1024 + (hh < 8 ? 0 : 512) + 64 * hd;
            attn_lds_ctx(st, qf, kl, vl, pr, r, h, rpb_l);
        }
        const float l = st.l + __shfl_xor(st.l, 32), inv = 1.f / l;
#pragma unroll
        for (int g = 0; g < 4; ++g) {
            u32x2 o; o.x = pk2(st.o0[4 * g] * inv, st.o0[4 * g + 1] * inv); o.y = pk2(st.o0[4 * g + 2] * inv, st.o0[4 * g + 3] * inv);
            *(u32x2*)(outp + 8 * g + 4 * h) = o;
            o.x = pk2(st.o1[4 * g] * inv, st.o1[4 * g + 1] * inv); o.y = pk2(st.o1[4 * g + 2] * inv, st.o1[4 * g + 3] * inv);
            *(u32x2*)(outp + 32 + 8 * g + 4 * h) = o;
        }
    }
}
constexpr int N_PHASES = 9;
#ifndef LATE_D_IN_P7
#define LATE_D_IN_P7 0
#endif
#ifndef LATE_GU_IN_P2
#define LATE_GU_IN_P2 0
#endif
#ifndef USE_G128
#define USE_G128 0
#endif
#ifndef TS_PROBE
#define TS_PROBE 0
#endif
#ifndef DUP_MASK
#define DUP_MASK 0
#endif
__global__ void __launch_bounds__(512, 2) fwd_mega(Args args) {
    extern __shared__ __attribute__((aligned(16))) unsigned char lds_raw[];
    LAS unsigned char* lds = (LAS unsigned char*)lds_raw;
    cg::grid_group grid = cg::this_grid();
    const int lo = args.ph_lo, hi = args.ph_hi;
    const bool fuse56 = gridDim.x >= 160;
    unsigned char* ws = args.ws;
#ifndef PHASE_MASK
#define PHASE_MASK 0x1ff
#endif
#define IN(k) (((PHASE_MASK >> (k)) & 1) && lo <= (k) && (k) < hi)
#define SEAM(k) do { if (IN(k) && IN((k) + 1)) xcd_barrier(xb); STAMP((k) + 1); } while (0)
#if TS_PROBE
#define STAMP(i) do { if (blockIdx.x == 0 && threadIdx.x == 0) ((unsigned long long*)(ws + WS_CTL + 116736))[i] = __builtin_amdgcn_s_memrealtime(); } while (0)
#else
#define STAMP(i) do { } while (0)
#endif
    if (lo < 0) grid.sync();
    volatile LAS unsigned* xst = (volatile LAS unsigned*)(lds + LDS_XB);
    if (threadIdx.x < 4) xst[threadIdx.x] = 0u;
    __syncthreads();
    XcdBarrier xb; xb.bar = (unsigned*)(ws + WS_CTL + CTL_BAR); xb.x = 0; xb.st = xst;
    if (hi - lo > 1) xb = xcd_barrier_post((unsigned*)(ws + WS_CTL + CTL_BAR), xst);
    STAMP(0);
    if (IN(0)) { p0_prologue(args, lds, true); if (DUP_MASK & 1) p0_prologue(args, lds, false); }
    STAMP(1);
    if (IN(1)) { norm_mod_phase(args, 0); if (DUP_MASK & 2) norm_mod_phase(args, 0); }
    SEAM(1);
    if (DUP_MASK & 512) { for (int q = 0; q < 8; ++q) xcd_barrier(xb); }
    if (IN(2)) {
        pg8::Gemm g{(const pg8::bf16_t*)(ws + WS_H), (const pg8::bf16_t*)(ws + WS_WIN), MTOK, DIN, DM}; pg8::StaticOrder S; S.init(MTOK, DIN, gridDim.x, blockIdx.x, (DUP_MASK & 4) ? 2 : 1);
        EpiIn E{&args, lds};
        pg8::gemm_phase<EpiIn, pg8::StaticOrder, true, true>(lds, g, S, E);
        if ((int)gridDim.x >= LATE_MIN_GRID) { const int busy = (40 * 17) % (int)gridDim.x;
            if (busy > 0 && (int)blockIdx.x >= busy) { p0_late_transposes(args, lds, 0, blockIdx.x - busy, gridDim.x - busy); if (LATE_GU_IN_P2) p0_late_transposes(args, lds, 1, blockIdx.x - busy, gridDim.x - busy); }
            else if (busy == 0) { p0_late_transposes(args, lds, 0, blockIdx.x, gridDim.x); if (LATE_GU_IN_P2) p0_late_transposes(args, lds, 1, blockIdx.x, gridDim.x); } }
    }
    SEAM(2);
    if (IN(3)) { attn_phase(args, 0, lds); if (DUP_MASK & 8) attn_phase(args, 1, lds); }
    SEAM(3);
    if (IN(4)) {
        if (!LATE_GU_IN_P2 && !USE_G128 && (int)gridDim.x >= LATE_MIN_GRID && blockIdx.x >= 160) p0_late_transposes(args, lds, 1, blockIdx.x - 160, gridDim.x - 160);
        pg8::StaticOrder S; S.init(MTOK, DM, gridDim.x, blockIdx.x, (DUP_MASK & 16) ? 2 : 1);
        { pg8::Gemm g{(const pg8::bf16_t*)(ws + WS_YA), (const pg8::bf16_t*)(ws + WS_WOA), MTOK, DM, 1024}; EpiGate E{&args};
          if (USE_G128) gemm128_phase<EpiGate>(lds, g, E); else pg8::gemm_phase<EpiGate, pg8::StaticOrder, true, true>(lds, g, S, E); }
        STAMP(10);
    }
    SEAM(4);
    if (IN(5)) {
        if ((int)gridDim.x >= LATE_MIN_GRID && blockIdx.x >= 160) { if (USE_G128) p0_late_transposes(args, lds, 1, blockIdx.x - 160, gridDim.x - 160); if (!LATE_D_IN_P7) p0_late_transposes(args, lds, 2, blockIdx.x - 160, gridDim.x - 160); }
        pg8::Gemm g{(const pg8::bf16_t*)(ws + WS_T), (const pg8::bf16_t*)(ws + WS_WO), MTOK, DM, DM}; pg8::StaticOrder S; S.init(MTOK, DM, gridDim.x, blockIdx.x, (DUP_MASK & 32) ? 2 : 1);
        if (fuse56) { EpiResNorm E{&args}; pg8::gemm_phase<EpiResNorm, pg8::StaticOrder, false, true>(lds, g, S, E); }
        else { EpiRes<0> E{&args}; pg8::gemm_phase<EpiRes<0>, pg8::StaticOrder, true, true>(lds, g, S, E); }
    }
    SEAM(5);
    if (!fuse56) {
    if (IN(6)) { norm_mod_phase(args, 1); }
    SEAM(6);
    }
    if (IN(7)) {
        pg8::Gemm g{(const pg8::bf16_t*)(ws + WS_H), (const pg8::bf16_t*)(ws + WS_WGU), MTOK, NGU, DM}; pg8::StaticOrder S; S.init(MTOK, NGU, gridDim.x, blockIdx.x, (DUP_MASK & 128) ? 2 : 1);
        EpiSwiglu E{&args};
        pg8::gemm_phase<EpiSwiglu, pg8::StaticOrder, true, true>(lds, g, S, E);
        if (LATE_D_IN_P7 && (int)gridDim.x >= LATE_MIN_GRID) { const int busy = (40 * 22) % (int)gridDim.x;
            if (busy > 0 && (int)blockIdx.x >= busy) p0_late_transposes(args, lds, 2, blockIdx.x - busy, gridDim.x - busy); else if (busy == 0) p0_late_transposes(args, lds, 2, blockIdx.x, gridDim.x); }
    }
    SEAM(7);
    if (IN(8)) {
        pg8::Gemm g{(const pg8::bf16_t*)(ws + WS_GU), (const pg8::bf16_t*)(ws + WS_WD), MTOK, DM, DFF}; pg8::StaticOrder S; S.init(MTOK, DM, gridDim.x, blockIdx.x, (DUP_MASK & 256) ? 2 : 1);
        EpiRes<1> E{&args};
        pg8::gemm_phase<EpiRes<1>, pg8::StaticOrder, true, false>(lds, g, S, E);
    }
#if TS_PROBE
    STAMP(9);
    if (blockIdx.x == 0 && threadIdx.x == 0) {
        const unsigned long long* ts = (const unsigned long long*)(ws + WS_CTL + 116736);
        const int sI[11] = {0, 1, 2, 3, 4, 5, 6, 6, 8, 4, 0}, eI[11] = {1, 2, 3, 4, 5, 6, 6, 8, 9, 10, 9};
        const unsigned long long d = ts[eI[TS_PROBE - 1]] - ts[sI[TS_PROBE - 1]];
        const unsigned long long t_end = __builtin_amdgcn_s_memrealtime() + 10ull * d;
        while (__builtin_amdgcn_s_memrealtime() < t_end) __builtin_amdgcn_s_sleep(8);
    }
#endif
#undef IN
#undef SEAM
}

#ifndef N_LAUNCH_MODE
#define N_LAUNCH_MODE 1
#endif
extern "C" void kernel_launch(void* const* d_in, const int* in_sizes, int n_in, void* d_out, int out_size, void* d_ws, size_t ws_size, hipStream_t stream) {
    static int grid = 0;
    if (grid == 0) {
        int dev = 0, cus = 0, per_cu = 0;
        (void)hipGetDevice(&dev);
        (void)hipDeviceGetAttribute(&cus, hipDeviceAttributeMultiprocessorCount, dev);
        (void)hipFuncSetAttribute((const void*)fwd_mega, hipFuncAttributeMaxDynamicSharedMemorySize, LDS_BYTES);
        (void)hipOccupancyMaxActiveBlocksPerMultiprocessor(&per_cu, (const void*)fwd_mega, 512, LDS_BYTES);
        if (per_cu < 1) { fprintf(stderr, "occupancy query says %d blocks/CU\n", per_cu); per_cu = 1; }
        if (per_cu > 1) per_cu = 1;
        grid = cus * per_cu;
        if (n_in != 25) fprintf(stderr, "kernel_launch: expected 25 inputs, got %d\n", n_in);
    }
    (void)hipMemsetAsync((char*)d_ws + WS_CTL, 0, CTL_BYTES, stream);
    Args a{};
    for (int i = 0; i < 25; ++i) a.in[i] = (const float*)d_in[i];
    a.out = (float*)d_out; a.ws = (unsigned char*)d_ws;
    if (N_LAUNCH_MODE == 1 || N_LAUNCH_MODE == 2) {
        a.ph_lo = 0; a.ph_hi = N_PHASES;
        void* kargs[] = {&a};
        hipError_t e = hipLaunchCooperativeKernel((const void*)fwd_mega, dim3(grid), dim3(512), kargs, LDS_BYTES, stream);
        if (e != hipSuccess) fprintf(stderr, "cooperative launch failed: %s (grid %d)\n", hipGetErrorString(e), grid);
        if (N_LAUNCH_MODE == 2) {
            (void)hipMemsetAsync((char*)d_ws + WS_CTL + 81920, 0, CTL_BYTES - 81920, stream);
            (void)hipLaunchCooperativeKernel((const void*)fwd_mega, dim3(grid), dim3(512), kargs, LDS_BYTES, stream); }
    } else {
        for (int p = 0; p < N_PHASES; ++p) { a.ph_lo = p; a.ph_hi = p + 1; hipLaunchKernelGGL(fwd_mega, dim3(grid), dim3(512), LDS_BYTES, stream, a); }
    }
}
```

```cpp
#include <hip/hip_runtime.h>
#include <hip/hip_cooperative_groups.h>
#include <cstdio>
#include <cstdint>
namespace cg = cooperative_groups;
namespace pg8 {
#define PG8_LAS __attribute__((address_space(3)))
typedef unsigned short bf16_t;
typedef short bf16x8 __attribute__((ext_vector_type(8)));
typedef float f32x4 __attribute__((ext_vector_type(4)));
typedef unsigned u32x4 __attribute__((ext_vector_type(4)));
constexpr int BM = 256, BK = 64, HALF = 128, HTB = HALF * BK * 2  , STAGE_BYTES = 8 * HTB, NXCD = 8, WGM = 4;

__host__ __device__ __forceinline__ int lds_byte(int r, int c) { const int st = (r >> 4) * 2 + (c >> 5), rr = r & 15, cc = c & 31, ob = rr * 64 + cc * 2; return st * 1024 + (ob ^ (((ob >> 9) & 1) << 5)); }
__host__ __device__ __forceinline__ void stage_rc(int b, int& R, int& C) { const int st = b / 1024, sb = b % 1024, swz = sb ^ (((sb >> 9) & 1) << 5); R = (st >> 1) * 16 + swz / 64; C = (st & 1) * 32 + (swz % 64) / 2; }
__host__ __device__ __forceinline__ int perm32(int rho) { const int n = rho >> 4, i = rho & 15; return 8 * (i >> 2) + 4 * n + (i & 3); }

struct Unit { int pm, pn; };
struct Gemm { const bf16_t* A; const bf16_t* Bt; int M, N, K; };

struct StaticOrder {
    int nM, nN, nwg, G, c, reps;
    __host__ __device__ void init(int M, int N, int G_, int c_, int reps_ = 1) { nM = M / BM; nN = N / BM; nwg = nM * nN; G = G_; c = c_; reps = reps_; }
    __host__ __device__ bool next(int i, Unit& u) const {
        const long L = (long)(i / reps) * G + c; if (L >= nwg) return false;
        int wgid = (int)L; { const int q = nwg / NXCD, r = nwg % NXCD, xcd = wgid % NXCD, off = wgid / NXCD; wgid = (xcd < r ? xcd * (q + 1) : r * (q + 1) + (xcd - r) * q) + off; }
        const int nig = WGM * nN, gid = wgid / nig, fm = gid * WGM, gsz = (nM - fm) < WGM ? (nM - fm) : WGM;
        u.pm = fm + ((wgid % nig) % gsz); u.pn = (wgid % nig) / gsz; return true;
    }
    __device__ __forceinline__ void a_ready(const Unit&) const {}
    __device__ __forceinline__ void done(const Unit&) const {}
};

__device__ __forceinline__ unsigned cvt_pk_bf16(float lo, float hi) { unsigned r; asm volatile("v_cvt_pk_bf16_f32 %0, %1, %2" : "=v"(r) : "v"(lo), "v"(hi)); return r; }

template <class Epi, class Sched, bool ALIGN_EPI = false, bool SP2 = false>
__device__ __forceinline__ void gemm_phase(PG8_LAS unsigned char* lds, const Gemm g, const Sched& S, const Epi& E) {
    int tid_ = threadIdx.x; asm volatile("" : "+v"(tid_));
    const int tid = tid_, wid = __builtin_amdgcn_readfirstlane(tid >> 6), lane = tid & 63, wr = wid >> 2, wc = wid & 3, fr = lane & 15, fq = lane >> 4;
    const int K = g.K, nt = K / BK;
    unsigned voffA[2], voffB[2];
#pragma unroll
    for (int i = 0; i < 2; ++i) { int R, C; stage_rc(tid * 16 + i * 8192, R, C); const int Rb = Epi::PERM ? ((R & ~31) + perm32(R & 31)) : R;
        voffA[i] = (unsigned)(R * K + C) * 2u; voffB[i] = (unsigned)(Rb * K + C) * 2u; }
    const size_t kstep = (size_t)(BK * 2);
    const size_t hstep = (size_t)HALF * K * 2;
    const size_t tstep = 2 * hstep;
    const unsigned ldsw = (unsigned)wid * 1024u;
    const int aoff = lds_byte(wr * 64 + fr, fq * 8), boff = lds_byte(wc * 32 + fr, fq * 8);
#define PG8_SA(b, h) (((b) * 2 + (h)) * HTB)
#define PG8_SB(b, h) ((4 + (b) * 2 + (h)) * HTB)
#define PG8_STAGE(bufoff, gbase, voff) do { _Pragma("unroll") for (int _i = 0; _i < 2; ++_i) \
        __builtin_amdgcn_global_load_lds((const unsigned*)((const char*)(gbase) + (voff)[_i]), (PG8_LAS unsigned*)(lds + (bufoff) + ldsw + _i * 8192), 16, 0, 0); } while (0)
#define PG8_LDA(dst, b, h) do { _Pragma("unroll") for (int m = 0; m < 4; ++m) _Pragma("unroll") for (int k = 0; k < 2; ++k) dst[m][k] = *(const PG8_LAS bf16x8*)(lds + PG8_SA(b, h) + aoff + m * 2048 + k * 1024); } while (0)
#define PG8_LDB(dst, b, h) do { _Pragma("unroll") for (int n = 0; n < 2; ++n) _Pragma("unroll") for (int k = 0; k < 2; ++k) dst[n][k] = *(const PG8_LAS bf16x8*)(lds + PG8_SB(b, h) + boff + n * 2048 + k * 1024); } while (0)
#define PG8_MMA(ai, bj, At, Bt) do { __builtin_amdgcn_s_setprio(1); _Pragma("unroll") for (int m = 0; m < 4; ++m) _Pragma("unroll") for (int n = 0; n < 2; ++n) _Pragma("unroll") for (int k = 0; k < 2; ++k) \
        acc[ai][bj][m][n] = __builtin_amdgcn_mfma_f32_16x16x32_bf16(Bt[n][k], At[m][k], acc[ai][bj][m][n], 0, 0, 0); __builtin_amdgcn_s_setprio(0); } while (0)
#define PG8_WAIT_V(n) asm volatile("s_waitcnt vmcnt(" #n ")" ::: "memory")
#define PG8_WAIT_L(n) asm volatile("s_waitcnt lgkmcnt(" #n ")" ::: "memory")
#define PG8_BAR __builtin_amdgcn_s_barrier()
#define PG8_SCHED __builtin_amdgcn_sched_barrier(0)
    Unit cur, nxt; int ui = 0;
    if (!S.next(0, cur)) return;
    f32x4 acc[2][2][4][2];
#pragma unroll
    for (int a = 0; a < 2; ++a)
#pragma unroll
        for (int b = 0; b < 2; ++b)
#pragma unroll
            for (int m = 0; m < 4; ++m)
#pragma unroll
                for (int n = 0; n < 2; ++n) acc[a][b][m][n] = (f32x4){0.f, 0.f, 0.f, 0.f};
    bf16x8 At[4][2], B0[2][2], B1[2][2];
    const char* cA = (const char*)g.A + (size_t)cur.pm * tstep; const char* cB = (const char*)g.Bt + (size_t)cur.pn * tstep;
    S.a_ready(cur);
    if constexpr (SP2) {
        PG8_STAGE(PG8_SB(0, 0), cB, voffB); PG8_STAGE(PG8_SB(0, 1), cB + hstep, voffB); PG8_STAGE(PG8_SA(0, 0), cA, voffA); PG8_STAGE(PG8_SA(0, 1), cA + hstep, voffA);
        if (wr == 1) PG8_BAR;
        PG8_WAIT_V(2); PG8_BAR;
        PG8_STAGE(PG8_SB(1, 0), cB + kstep, voffB); PG8_STAGE(PG8_SA(1, 0), cA + kstep, voffA); PG8_STAGE(PG8_SB(1, 1), cB + hstep + kstep, voffB);
        PG8_WAIT_V(6); PG8_BAR;
    } else {
        PG8_STAGE(PG8_SB(0, 0), cB, voffB); PG8_STAGE(PG8_SA(0, 0), cA, voffA); PG8_STAGE(PG8_SB(0, 1), cB + hstep, voffB); PG8_STAGE(PG8_SA(0, 1), cA + hstep, voffA);
        if (wr == 1) PG8_BAR;
        PG8_WAIT_V(4); PG8_BAR;
        PG8_STAGE(PG8_SB(1, 0), cB + kstep, voffB); PG8_STAGE(PG8_SA(1, 0), cA + kstep, voffA); PG8_STAGE(PG8_SB(1, 1), cB + hstep + kstep, voffB);
        PG8_WAIT_V(6); PG8_BAR;
    }
    for (;;) {
        const bool has_next = S.next(ui + 1, nxt);
        const char* nA = has_next ? (const char*)g.A + (size_t)nxt.pm * tstep : cA; const char* nB = has_next ? (const char*)g.Bt + (size_t)nxt.pn * tstep : cB;
        for (int t = 0; t < nt; t += 2) {
            const bool last = (t == nt - 2);
            const char* a1 = cA + (size_t)(t + 1) * kstep;
            const char* a2 = last ? nA : cA + (size_t)(t + 2) * kstep; const char* b2 = last ? nB : cB + (size_t)(t + 2) * kstep;
            const char* a3 = a2 + kstep; const char* b3 = b2 + kstep;
            if (last && has_next) S.a_ready(nxt);
            if constexpr (Epi::HAS_MID) { if (t == Epi::MID_T) E.mid(acc, cur, wr, wc, fr, fq); }
            if constexpr (SP2) {
            PG8_LDB(B0, 0, 0); PG8_LDB(B1, 0, 1); PG8_SCHED; PG8_LDA(At, 0, 0); PG8_STAGE(PG8_SA(1, 1), a1 + hstep, voffA);
            PG8_WAIT_V(8); PG8_WAIT_L(0); PG8_BAR; PG8_MMA(0, 0, At, B0); PG8_MMA(0, 1, At, B1); PG8_BAR; PG8_SCHED;
            PG8_LDA(At, 0, 1); PG8_STAGE(PG8_SB(0, 0), b2, voffB); PG8_STAGE(PG8_SB(0, 1), b2 + hstep, voffB); PG8_STAGE(PG8_SA(0, 0), a2, voffA);
            PG8_WAIT_V(8); PG8_WAIT_L(0); PG8_BAR; PG8_MMA(1, 0, At, B0); PG8_MMA(1, 1, At, B1); PG8_BAR; PG8_SCHED;
            PG8_LDB(B0, 1, 0); PG8_LDB(B1, 1, 1); PG8_SCHED; PG8_LDA(At, 1, 0); PG8_STAGE(PG8_SA(0, 1), a2 + hstep, voffA);
            PG8_WAIT_V(8); PG8_WAIT_L(0); PG8_BAR; PG8_MMA(0, 0, At, B0); PG8_MMA(0, 1, At, B1); PG8_BAR; PG8_SCHED;
            PG8_LDA(At, 1, 1); PG8_STAGE(PG8_SB(1, 0), b3, voffB); PG8_STAGE(PG8_SB(1, 1), b3 + hstep, voffB); PG8_STAGE(PG8_SA(1, 0), a3, voffA);
            PG8_WAIT_V(8); PG8_WAIT_L(0); PG8_BAR; PG8_MMA(1, 0, At, B0); PG8_MMA(1, 1, At, B1); PG8_BAR; PG8_SCHED;
            } else {
            PG8_LDB(B0, 0, 0); PG8_SCHED; PG8_LDA(At, 0, 0); PG8_STAGE(PG8_SA(1, 1), a1 + hstep, voffA);
            PG8_WAIT_L(8); PG8_BAR; PG8_WAIT_L(0); PG8_MMA(0, 0, At, B0); PG8_BAR; PG8_SCHED;
            PG8_LDB(B1, 0, 1); PG8_STAGE(PG8_SB(0, 0), b2, voffB);
            PG8_BAR; PG8_WAIT_L(0); PG8_MMA(0, 1, At, B1); PG8_BAR;
            PG8_LDA(At, 0, 1); PG8_STAGE(PG8_SA(0, 0), a2, voffA);
            PG8_BAR; PG8_WAIT_L(0); PG8_MMA(1, 0, At, B0); PG8_BAR; PG8_SCHED;
            PG8_STAGE(PG8_SB(0, 1), b2 + hstep, voffB);
            PG8_WAIT_V(6); PG8_BAR; PG8_MMA(1, 1, At, B1); PG8_BAR;
            PG8_LDB(B0, 1, 0); PG8_SCHED; PG8_LDA(At, 1, 0); PG8_STAGE(PG8_SA(0, 1), a2 + hstep, voffA);
            PG8_WAIT_L(8); PG8_BAR; PG8_WAIT_L(0); PG8_MMA(0, 0, At, B0); PG8_BAR; PG8_SCHED;
            PG8_LDB(B1, 1, 1); PG8_STAGE(PG8_SB(1, 0), b3, voffB);
            PG8_BAR; PG8_WAIT_L(0); PG8_MMA(0, 1, At, B1); PG8_BAR;
            PG8_LDA(At, 1, 1); PG8_STAGE(PG8_SA(1, 0), a3, voffA);
            PG8_BAR; PG8_WAIT_L(0); PG8_MMA(1, 0, At, B0); PG8_BAR; PG8_SCHED;
            PG8_STAGE(PG8_SB(1, 1), b3 + hstep, voffB);
            PG8_WAIT_V(6); PG8_BAR; PG8_MMA(1, 1, At, B1); PG8_BAR;
            }
        }
        if constexpr (ALIGN_EPI) { if (wr == 0) PG8_BAR; }
        if constexpr (!Epi::AFTER_DRAIN) { E(acc, cur, wr, wc, fr, fq); S.done(cur); }
        if (!has_next) break;
#pragma unroll
        for (int a = 0; a < 2; ++a)
#pragma unroll
            for (int b = 0; b < 2; ++b)
#pragma unroll
                for (int m = 0; m < 4; ++m)
#pragma unroll
                    for (int n = 0; n < 2; ++n) acc[a][b][m][n] = (f32x4){0.f, 0.f, 0.f, 0.f};
        cur = nxt; cA = nA; cB = nB; ++ui;
        if constexpr (ALIGN_EPI) { if (wr == 1) PG8_BAR; }
    }
    PG8_WAIT_V(0);
    if constexpr (!ALIGN_EPI) { if (wr == 0) PG8_BAR; }
    PG8_BAR;
    if constexpr (Epi::AFTER_DRAIN) { E.fused(acc, cur, wr, wc, fr, fq, lds, wid, lane); S.done(cur); }
#undef PG8_SA
#undef PG8_SB
#undef PG8_STAGE
#undef PG8_LDA
#undef PG8_LDB
#undef PG8_MMA
#undef PG8_WAIT_V
#undef PG8_WAIT_L
#undef PG8_BAR
#undef PG8_SCHED
}
}

#define DI __device__ __forceinline__
#define LAS __attribute__((address_space(3)))
typedef unsigned short u16;
typedef float f32x4 __attribute__((ext_vector_type(4)));
typedef float f32x16 __attribute__((ext_vector_type(16)));
typedef float f32x2 __attribute__((ext_vector_type(2)));
typedef short bf16x8 __attribute__((ext_vector_type(8)));
typedef short s16x4 __attribute__((ext_vector_type(4)));
typedef unsigned u32x2 __attribute__((ext_vector_type(2)));
typedef unsigned u32x4 __attribute__((ext_vector_type(4)));
typedef __bf16 bf16x2_t __attribute__((ext_vector_type(2)));

constexpr int DM = 1024, NCTX = 8192, NLAT = 2048, MTOK = 10240, DIN = 4352, DFF = 2816, NGU = 2 * DFF;
constexpr int QKV_P = 2304, G_P = 2048;
constexpr size_t MiB = 1u << 20;
constexpr size_t WS_CTL = 0, CTL_BYTES = 128 * 1024, CTL_QUEUE = 81920;
constexpr size_t CTL_BAR = 90112;
constexpr size_t CTL_ADAFLAG = 86016;
constexpr size_t CTL_PANEL = 104448;
constexpr size_t WS_ROPE = 512 * 1024;
constexpr size_t WS_SHW = 640 * 1024;
constexpr size_t WS_RSS = 231 * MiB;
constexpr size_t WS_WIN = 1 * MiB, WS_WOA = 10 * MiB, WS_WOB = 11 * MiB, WS_WO = 12 * MiB, WS_WGU = 14 * MiB, WS_WD = 25 * MiB;
constexpr size_t WS_CKA = 31 * MiB, WS_CKB = 31 * MiB + 128 * 1024, WS_VCA = 32 * MiB, WS_VCB = 32 * MiB + 128 * 1024;
constexpr size_t WS_VTA_CTX = 33 * MiB, WS_VTB_CTX = 35 * MiB, WS_VTA_LAT = 43 * MiB, WS_VTB_LAT = 44 * MiB;
constexpr size_t WS_H = 46 * MiB, WS_QKV = 66 * MiB, WS_G = 111 * MiB, WS_YA = 151 * MiB, WS_YB = 161 * MiB, WS_TMP = 171 * MiB, WS_T = 211 * MiB, WS_GU = 66 * MiB;
constexpr size_t OUT_Y = 0, OUT_AK = 10485760, OUT_AV = 11534336, OUT_BK = 12582912, OUT_BV = 16777216;
constexpr int LDS_BYTES = 147456, LDS_XB = 147456 - 64;
constexpr float RMS_EPS = 1e-6f;

DI unsigned pk2(float lo, float hi) { f32x2 v = {lo, hi}; bf16x2_t b = __builtin_convertvector(v, bf16x2_t); return __builtin_bit_cast(unsigned, b); }
DI u16 bf1(float x) { return (u16)(pk2(x, 0.f) & 0xffffu); }
DI float wave_sum(float v) {
#pragma unroll
    for (int o = 1; o < 64; o <<= 1) v += __shfl_xor(v, o);
    return v;
}
DI float sigmoidf_(float x) { return 1.0f / (1.0f + __expf(-x)); }
DI float siluf_(float x) { return x / (1.0f + __expf(-x)); }

struct Args { const float* in[25]; float* out; unsigned char* ws; int ph_lo, ph_hi; };
enum { I_XP = 0, I_XS, I_CAK, I_CAV, I_CBK, I_CBV, I_C, I_CCTX, I_WADA, I_BADA, I_GATTN, I_WIN, I_QNA, I_KNA, I_QNB, I_KNB, I_SINK, I_RPB, I_WOA, I_WOB, I_WO, I_GFFN, I_WG, I_WU, I_WD };

DI int dest_row(int mode, int n) {
    if (mode == 0) return n;
    if (mode == 1) { const int pn = n >> 8, wc = (n >> 6) & 3, bj = (n >> 5) & 1, e = n & 31; return (pn << 8) + (bj << 7) + (wc << 5) + e; }
    const int pn = n >> 7, rem = n & 127, bj = rem >> 6, wc = (rem >> 4) & 3, e = rem & 15;
    return (pn << 8) + (bj << 7) + (wc << 5) + ((mode == 3) ? 16 : 0) + e;
}
DI void p0_transpose_block(const float* W, int K, int N, u16* WT, int mode, LAS float* scr, int item, int tid, int ldk = 0, int koff = 0) {
    if (ldk == 0) ldk = K;
    const int nblk = N / 256, kb = item / nblk, nb = item % nblk, k0 = 64 * kb, n0 = 256 * nb;
    const int lane = tid & 63, wave = tid >> 6;
#pragma unroll
    for (int i = 0; i < 8; ++i) { const int kk = wave * 8 + i; const f32x4 v = __builtin_nontemporal_load((const f32x4*)(W + (size_t)(k0 + kk) * N + n0 + 4 * lane));
        LAS float* d = scr + kk * 257 + 4 * lane; d[0] = v.x; d[1] = v.y; d[2] = v.z; d[3] = v.w; }
    __syncthreads();
    const int c = lane & 7;
#pragma unroll
    for (int j = 0; j < 4; ++j) { const int n = wave * 32 + j * 8 + (lane >> 3); const LAS float* sp = scr + (8 * c) * 257 + n;
        u32x4 o; o.x = pk2(sp[0 * 257], sp[1 * 257]); o.y = pk2(sp[2 * 257], sp[3 * 257]); o.z = pk2(sp[4 * 257], sp[5 * 257]); o.w = pk2(sp[6 * 257], sp[7 * 257]);
        *(u32x4*)(WT + (size_t)dest_row(mode, n0 + n) * ldk + koff + k0 + 8 * c) = o; }
    __syncthreads();
}

constexpr int LATE_MIN_GRID = 192;
DI void p0_late_transposes(const Args& a, LAS unsigned char* lds, int which, int first, int stride) {
    LAS float* scr = (LAS float*)lds; unsigned char* ws = a.ws; int tid = threadIdx.x; asm volatile("" : "+v"(tid));
    constexpr int I_OA = 8 * 4, I_OB = 8 * 4, I_O = 16 * 4, I_G = 16 * (DFF / 256), I_U = I_G, I_D = (DFF / 64) * 4;
    if (which == 0) for (int it = first; it < I_OA + I_OB + I_O; it += stride) {
        int r = it;
        if (r < I_OA) { p0_transpose_block(a.in[I_WOA], 512, DM, (u16*)(ws + WS_WOA), 0, scr, r, tid, 1024, 0); continue; } r -= I_OA;
        if (r < I_OB) { p0_transpose_block(a.in[I_WOB], 512, DM, (u16*)(ws + WS_WOA), 0, scr, r, tid, 1024, 512); continue; } r -= I_OB;
        p0_transpose_block(a.in[I_WO], DM, DM, (u16*)(ws + WS_WO), 0, scr, r, tid);
    }
    if (which == 1) for (int it = first; it < I_G + I_U; it += stride) {
        if (it < I_G) p0_transpose_block(a.in[I_WG], DM, DFF, (u16*)(ws + WS_WGU), 2, scr, it, tid);
        else p0_transpose_block(a.in[I_WU], DM, DFF, (u16*)(ws + WS_WGU), 3, scr, it - I_G, tid);
    }
    if (which == 2) for (int it = first; it < I_D; it += stride) p0_transpose_block(a.in[I_WD], DFF, DM, (u16*)(ws + WS_WD), 0, scr, it, tid);
}
DI void shw_rows(const Args& a, int first, int stride) {
    int tid_ = threadIdx.x; asm volatile("" : "+v"(tid_));
    const int lane = tid_ & 63, wave = tid_ >> 6;
    const float* ada = (const float*)(a.ws + WS_CTL); const u16* W = (const u16*)(a.ws + WS_WGU); float* shw = (float*)(a.ws + WS_SHW);
    f32x4 sh[3][4];
#pragma unroll
    for (int g = 0; g < 3; ++g)
#pragma unroll
        for (int q = 0; q < 4; ++q) sh[g][q] = *(const f32x4*)(ada + g * 6144 + 3072 + 16 * lane + 4 * q);
    for (int n = first * 8 + wave; n < NGU; n += stride * 8) {
        const u32x4 w0 = *(const u32x4*)(W + (size_t)n * DM + 16 * lane), w1 = *(const u32x4*)(W + (size_t)n * DM + 16 * lane + 8);
        const unsigned ww[8] = {w0.x, w0.y, w0.z, w0.w, w1.x, w1.y, w1.z, w1.w};
        float d0 = 0.f, d1 = 0.f, d2 = 0.f;
#pragma unroll
        for (int q = 0; q < 8; ++q) { const float lo = __uint_as_float(ww[q] << 16), hi = __uint_as_float(ww[q] & 0xffff0000u); const int e = 2 * q;
            d0 += lo * sh[0][e >> 2][e & 3] + hi * sh[0][(e + 1) >> 2][(e + 1) & 3];
            d1 += lo * sh[1][e >> 2][e & 3] + hi * sh[1][(e + 1) >> 2][(e + 1) & 3];
            d2 += lo * sh[2][e >> 2][e & 3] + hi * sh[2][(e + 1) >> 2][(e + 1) & 3]; }
        d0 = wave_sum(d0); d1 = wave_sum(d1); d2 = wave_sum(d2);
        if (lane == 0) { shw[n] = d0; shw[NGU + n] = d1; shw[2 * NGU + n] = d2; }
    }
}
DI void p0_prologue(const Args& a, LAS unsigned char* lds, bool do_ada) {
    (void)do_ada;
    int tid_ = threadIdx.x; asm volatile("" : "+v"(tid_));
    const int tid = tid_, lane = tid & 63, wave = __builtin_amdgcn_readfirstlane(tid >> 6);
    const int gw = blockIdx.x * 8 + wave, NGW = gridDim.x * 8;
    unsigned char* ws = a.ws;
    float* ada = (float*)(ws + WS_CTL);
    {
        LAS float* red = (LAS float*)lds;
        for (int it = blockIdx.x; it < 24 * 8; it += gridDim.x) {
            const int cgp = it % 24, kc = it / 24, col = cgp * 256 + 4 * lane, kbase = kc * 128 + wave * 16;
            const float* wp = a.in[I_WADA] + (size_t)kbase * 6144 + col;
            f32x4 acc0 = {0, 0, 0, 0}, acc1 = acc0, acc2 = acc0;
#pragma unroll
            for (int k = 0; k < 16; ++k) {
                const f32x4 w = __builtin_nontemporal_load((const f32x4*)(wp + (size_t)k * 6144));
                const int kk = kbase + k;
                const float s0 = siluf_(a.in[I_CCTX][kk]), s1 = siluf_(a.in[I_C][kk]), s2 = siluf_(a.in[I_C][1024 + kk]);
                acc0 += w * s0; acc1 += w * s1; acc2 += w * s2;
            }
#pragma unroll
            for (int j = 0; j < 4; ++j) { red[(wave * 3 + 0) * 256 + 4 * lane + j] = acc0[j]; red[(wave * 3 + 1) * 256 + 4 * lane + j] = acc1[j]; red[(wave * 3 + 2) * 256 + 4 * lane + j] = acc2[j]; }
            __syncthreads();
            for (int idx = tid; idx < 768; idx += 512) { const int v = idx >> 8, c = idx & 255; float t = kc == 0 ? a.in[I_BADA][cgp * 256 + c] : 0.f;
#pragma unroll
                for (int q = 0; q < 8; ++q) t += red[(q * 3 + v) * 256 + c];
                atomicAdd(ada + v * 6144 + cgp * 256 + c, t); }
            __syncthreads();
        }
    }
    if (tid == 0 && (int)blockIdx.x < 24 * 8) { __threadfence(); atomicAdd((unsigned*)(ws + WS_CTL + CTL_ADAFLAG), 1u); }
    {
        LAS float* scr = (LAS float*)lds;
        constexpr int I_IN = 16 * (DIN / 256);
        for (int it = gridDim.x - 1 - blockIdx.x; it < I_IN; it += gridDim.x) p0_transpose_block(a.in[I_WIN], DM, DIN, (u16*)(ws + WS_WIN), 1, scr, it, tid);
        if ((int)gridDim.x < LATE_MIN_GRID) { p0_late_transposes(a, lds, 0, blockIdx.x, gridDim.x); p0_late_transposes(a, lds, 1, blockIdx.x, gridDim.x); p0_late_transposes(a, lds, 2, blockIdx.x, gridDim.x); }
    }
    if (blockIdx.x == 0) { for (int i = tid; i < 64 * 16; i += 512) { const int pos = i >> 4, fi = i & 15; const float ang = (float)pos * exp2f(-(float)fi * (13.287712379549449f / 16.0f));
        float* rt = (float*)(ws + WS_ROPE) + (pos * 4 + (fi >> 2)) * 8 + (fi & 3); rt[0] = cosf(ang); rt[4] = sinf(ang); } }
    const int gt = blockIdx.x * 512 + tid, NGT = gridDim.x * 512;
    for (int i = gt; i < 2 * 256 * 128 / 4; i += NGT) { const f32x4 v = *(const f32x4*)(a.in[I_CAK] + 4 * i); u32x2 o; o.x = pk2(v.x, v.y); o.y = pk2(v.z, v.w); *(u32x2*)((u16*)(ws + WS_CKA) + 4 * i) = o; }
    for (int i = gt; i < 2 * 256 * 512 / 4; i += NGT) { const f32x4 v = *(const f32x4*)(a.in[I_CBK] + 4 * i); u32x2 o; o.x = pk2(v.x, v.y); o.y = pk2(v.z, v.w); *(u32x2*)((u16*)(ws + WS_CKB) + 4 * i) = o; }
    for (int it = gw; it < 128 + 512; it += NGW) {
        const bool isA = it < 128; const int j = isA ? it : it - 128, nh = isA ? 2 : 8;
        const int g = j & 31, hd = (j >> 5) % nh, b = (j >> 5) / nh;
        const float* src = a.in[isA ? I_CAV : I_CBV] + ((size_t)(b * 256 + 8 * g) * nh + hd) * 64 + lane;
        float v[8];
#pragma unroll
        for (int q = 0; q < 8; ++q) v[q] = src[(size_t)q * nh * 64];
        u32x4 o; o.x = pk2(v[0], v[1]); o.y = pk2(v[2], v[3]); o.z = pk2(v[4], v[5]); o.w = pk2(v[6], v[7]);
        *(u32x4*)((u16*)(ws + (isA ? WS_VCA : WS_VCB)) + ((size_t)(b * nh + hd) * 64 + lane) * 256 + 8 * g) = o;
    }
}

DI void norm_mod_phase(const Args& a, int which) {
    int tid_ = threadIdx.x; asm volatile("" : "+v"(tid_));
    const int tid = tid_, lane = tid & 63, wave = tid >> 6;
    if (which == 0) {
        if (tid == 0) { const unsigned want = (unsigned)min(24 * 8, (int)gridDim.x); unsigned* f = (unsigned*)(a.ws + WS_CTL + CTL_ADAFLAG); unsigned sp = 0;
            while (__hip_atomic_load(f, __ATOMIC_RELAXED, __HIP_MEMORY_SCOPE_AGENT) < want && ++sp < (1u << 22)) __builtin_amdgcn_s_sleep(2);
            __builtin_amdgcn_fence(__ATOMIC_ACQUIRE, "agent"); asm volatile("s_waitcnt vmcnt(0)" ::: "memory"); }
        __syncthreads();
    }
    const int gw = blockIdx.x * 8 + wave, NGW = gridDim.x * 8;
    const float* ada = (const float*)(a.ws + WS_CTL);
    const float* g = a.in[which ? I_GFFN : I_GATTN];
    u16* H = (u16*)(a.ws + WS_H);
    constexpr int RB = 5;
    for (int r0 = gw; r0 < MTOK; r0 += RB * NGW) {
        f32x4 v[RB][4];
#pragma unroll
        for (int i = 0; i < RB; ++i) { const int r = r0 + i * NGW;
            if (r < MTOK) { const float* xrow = which ? ((const float*)(a.ws + WS_TMP) + (size_t)r * DM) : (r < NCTX ? a.in[I_XP] + (size_t)r * DM : a.in[I_XS] + (size_t)(r - NCTX) * DM);
#pragma unroll
                for (int j = 0; j < 4; ++j) v[i][j] = __builtin_nontemporal_load((const f32x4*)(xrow + 4 * lane + 256 * j)); }
            else {
#pragma unroll
                for (int j = 0; j < 4; ++j) v[i][j] = (f32x4){0.f, 0.f, 0.f, 0.f}; } }
#pragma unroll
        for (int i = 0; i < RB; ++i) { const int r = r0 + i * NGW;
            if (r >= MTOK) break;
            const int grp = r < NCTX ? 0 : 1 + ((r - NCTX) >> 10);
            const float* sh = ada + grp * 6144 + (which ? 3072 : 0);
            const float* sc = sh + 1024;
            float ss = 0.f;
#pragma unroll
            for (int j = 0; j < 4; ++j) ss += (v[i][j].x * v[i][j].x + v[i][j].y * v[i][j].y) + (v[i][j].z * v[i][j].z + v[i][j].w * v[i][j].w);
            const float rstd = rsqrtf(wave_sum(ss) * (1.f / DM) + RMS_EPS);
#pragma unroll
            for (int j = 0; j < 4; ++j) {
                const int c = 4 * lane + 256 * j;
                const f32x4 gg = *(const f32x4*)(g + c), s1 = *(const f32x4*)(sc + c), s0 = *(const f32x4*)(sh + c);
                const f32x4 y = (v[i][j] * rstd * gg) * (s1 + 1.0f) + s0;
                u32x2 o; o.x = pk2(y.x, y.y); o.y = pk2(y.z, y.w);
                *(u32x2*)(H + (size_t)r * DM + c) = o;
            }
        }
    }
}
#define XB_TMO      128
#define XB_XCNT(j)  (256  + 64 * (j))
#define XB_XSUB(j)  (1280 + 64 * (j))
#define XB_XGEN(j)  (2304 + 64 * (j))
#define XB_TOP      3328
#define XB_TOPGEN   3392
#define XCD_BAR_WORDS 3456
#define XB_SPIN_CAP (1u << 18)

__device__ __forceinline__ unsigned xb_ld(unsigned* p)              { return __hip_atomic_load(p, __ATOMIC_RELAXED, __HIP_MEMORY_SCOPE_AGENT); }
__device__ __forceinline__ unsigned xb_add(unsigned* p, unsigned v) { return __hip_atomic_fetch_add(p, v, __ATOMIC_RELAXED, __HIP_MEMORY_SCOPE_AGENT); }
__device__ __forceinline__ unsigned xb_xcc_id() { return (unsigned)__builtin_amdgcn_s_getreg((3 << 11) | 20) & 0xFu; }
#define XB_SPIN(cond, bar) do { unsigned _sp = 0; while (cond) { __builtin_amdgcn_s_sleep(1); \
    if ((++_sp & 255u) == 0u) { if (xb_ld(&(bar)[XB_TMO])) break; if (_sp > XB_SPIN_CAP) { atomicAdd(&(bar)[XB_TMO], 1u); break; } } } } while (0)

struct XcdBarrier {
    unsigned* bar; unsigned x;
    volatile LAS unsigned* st;
};

__device__ __forceinline__ XcdBarrier xcd_barrier_post(unsigned* bar, volatile LAS unsigned* st) {
    XcdBarrier b; b.bar = bar; b.x = xb_xcc_id(); b.st = st;
    if (threadIdx.x == 0) (void)xb_add(&bar[XB_XCNT(b.x)], 1u);
    return b;
}
__device__ __forceinline__ void xcd_barrier_complete(unsigned* bar, unsigned x, unsigned& nloc, unsigned& nx) {
    const unsigned G = gridDim.x * gridDim.y * gridDim.z;
    unsigned sum, cnt, mine, sp = 0u;
    for (;;) {
        sum = 0u; cnt = 0u; mine = 0u;
#pragma unroll
        for (unsigned j = 0; j < 16; ++j) { const unsigned c = xb_ld(&bar[XB_XCNT(j)]); sum += c; cnt += (c > 0u) ? 1u : 0u; mine = (j == x) ? c : mine; }
        if (sum == G) break;
        __builtin_amdgcn_s_sleep(1);
        if ((++sp & 255u) == 0u) { if (xb_ld(&bar[XB_TMO])) break; if (sp > XB_SPIN_CAP) { atomicAdd(&bar[XB_TMO], 1u); break; } }
    }
    nloc = mine > 0u ? mine : 1u; nx = cnt > 0u ? cnt : 1u;
}

__device__ __forceinline__ void xcd_barrier(const XcdBarrier& b) {
    asm volatile("s_waitcnt vmcnt(0)" ::: "memory");
    __syncthreads();
    if (threadIdx.x == 0) {
        unsigned* bar = b.bar;
        __builtin_amdgcn_s_waitcnt(0);
        unsigned nloc = b.st[0], nx = b.st[1];
        if (nloc == 0u) { xcd_barrier_complete(bar, b.x, nloc, nx); b.st[0] = nloc; b.st[1] = nx; }
        const unsigned old = xb_add(&bar[XB_XSUB(b.x)], 1u);
        const unsigned gen = old / nloc;
        if (old + 1u == (gen + 1u) * nloc) {
            __builtin_amdgcn_fence(__ATOMIC_RELEASE, "agent");
            asm volatile("s_waitcnt vmcnt(0)" ::: "memory");
            const unsigned og = xb_add(&bar[XB_TOP], 1u);
            const unsigned tg = og / nx;
            if (og + 1u == (tg + 1u) * nx) xb_add(&bar[XB_TOPGEN], 1u);
            else XB_SPIN(xb_ld(&bar[XB_TOPGEN]) == tg, bar);
            __builtin_amdgcn_fence(__ATOMIC_ACQUIRE, "agent");
            xb_add(&bar[XB_XGEN(b.x)], 1u);
            asm volatile("s_waitcnt vmcnt(0)" ::: "memory");
        } else {
            XB_SPIN(xb_ld(&bar[XB_XGEN(b.x)]) == gen, bar);
            __builtin_amdgcn_fence(__ATOMIC_ACQUIRE, "agent");
            asm volatile("s_waitcnt vmcnt(0)" ::: "memory");
        }
    }
    __syncthreads();
}

typedef const pg8::f32x4 (&AccRef)[2][2][4][2];

struct EpiIn {
    static constexpr bool PERM = false, AFTER_DRAIN = false, HAS_MID = false; static constexpr int MID_T = 0;
    const Args* a; LAS unsigned char* lds;
    DI void operator()(AccRef acc, const pg8::Unit& u, int wr, int wc, int fr, int fq) const {
        asm volatile("" : "+v"(fr), "+v"(fq));
        unsigned char* ws = a->ws;
        const int pn = u.pn, pm = u.pm;
        const bool lat = pm >= 32;
        const int row0 = pm * 256 + wr * 64 + fr;
        if (pn >= 9) {
            u16* G = (u16*)(ws + WS_G);
#pragma unroll
            for (int ai = 0; ai < 2; ++ai)
#pragma unroll
                for (int m = 0; m < 4; ++m) { u16* rp = G + (size_t)(row0 + ai * 128 + m * 16) * G_P + (pn - 9) * 256 + wc * 64 + 4 * fq;
#pragma unroll
                    for (int bj = 0; bj < 2; ++bj)
#pragma unroll
                        for (int n = 0; n < 2; ++n) { const pg8::f32x4 v = acc[ai][bj][m][n]; u32x2 o; o.x = pk2(sigmoidf_(v[0]), sigmoidf_(v[1])); o.y = pk2(sigmoidf_(v[2]), sigmoidf_(v[3]));
                            *(u32x2*)(rp + 32 * bj + 16 * n) = o; } }
            return;
        }
        const bool isv = (pn == 2 && wc >= 2) || pn == 7 || pn == 8;
        if (isv) {
            int nh, hd; u16* vt; float* ov;
            if (pn == 2) { nh = 2; hd = wc - 2; vt = (u16*)(ws + (lat ? WS_VTA_LAT : WS_VTA_CTX)); ov = a->out + OUT_AV; }
            else { nh = 8; hd = (pn - 7) * 4 + wc; vt = (u16*)(ws + (lat ? WS_VTB_LAT : WS_VTB_CTX)); ov = a->out + OUT_BV; }
            const int Tsh = lat ? 10 : 8;
            const int bb = lat ? (pm - 32) >> 2 : pm;
            const unsigned tb = (unsigned)((lat ? ((pm - 32) & 3) * 256 : 0) + wr * 64);
            u16* vb = vt + (((size_t)(bb * nh + hd) * 64) << Tsh);
            LAS u16* sc = (LAS u16*)(lds + 131072 + (wr * 4 + wc) * 1024);
            const int lane = fr + 16 * fq, dd = lane >> 2, tg = lane & 3;
            int blk = 0;
#pragma unroll
            for (int ai = 0; ai < 2; ++ai)
#pragma unroll
                for (int m = 0; m < 4; ++m) {
#pragma unroll
                    for (int bj = 0; bj < 2; ++bj)
#pragma unroll
                        for (int n = 0; n < 2; ++n) { const pg8::f32x4 v = acc[ai][bj][m][n]; const unsigned d = 32 * bj + 16 * n + 4 * fq;
                            LAS u16* sb = sc + (blk & 1) * 256; ++blk;
                            u32x2 w; w.x = pk2(v[0], v[1]); w.y = pk2(v[2], v[3]);
                            *(LAS u32x2*)(sb + fr * 16 + 4 * fq) = w;
                            const unsigned e0 = sb[(4 * tg + 0) * 16 + dd], e1 = sb[(4 * tg + 1) * 16 + dd], e2 = sb[(4 * tg + 2) * 16 + dd], e3 = sb[(4 * tg + 3) * 16 + dd];
                            u32x2 o; o.x = e0 | (e1 << 16); o.y = e2 | (e3 << 16);
                            *(u32x2*)(vb + ((32 * bj + 16 * n + dd) << Tsh) + tb + ai * 128 + m * 16 + 4 * tg) = o;
                            if (!lat) *(pg8::f32x4*)(ov + (unsigned)(((row0 + ai * 128 + m * 16) * nh + hd) * 64) + d) = v; }
                    __builtin_amdgcn_sched_barrier(0); }
            return;
        }
        const float* nw; float* ok = nullptr; int nh = 0, hd = 0; bool rope = false;
        const float qscale = (pn < 2 || pn == 3 || pn == 4) ? 0.125f * 1.4426950408889634f : 1.0f;
        if (pn < 2) { nw = a->in[I_QNA]; rope = lat; }
        else if (pn == 2) { nw = a->in[I_KNA]; rope = lat; ok = a->out + OUT_AK; nh = 2; hd = wc; }
        else if (pn < 5) { nw = a->in[I_QNB]; }
        else { nw = a->in[I_KNB]; ok = a->out + OUT_BK; nh = 8; hd = (pn - 5) * 4 + wc; }
        u16* Q = (u16*)(ws + WS_QKV);
        pg8::f32x4 wv[2][2];
#pragma unroll
        for (int bj = 0; bj < 2; ++bj)
#pragma unroll
            for (int n = 0; n < 2; ++n) wv[bj][n] = *(const pg8::f32x4*)(nw + 32 * bj + 16 * n + 4 * fq);
        const float* rtab = (const float*)(ws + WS_ROPE) + fq * 8;
#pragma unroll
        for (int ai = 0; ai < 2; ++ai)
#pragma unroll
            for (int m = 0; m < 4; ++m) {
                const int r = row0 + ai * 128 + m * 16;
                pg8::f32x4 v[2][2]; float ss = 0.f;
#pragma unroll
                for (int bj = 0; bj < 2; ++bj)
#pragma unroll
                    for (int n = 0; n < 2; ++n) { v[bj][n] = acc[ai][bj][m][n]; ss += (v[bj][n][0] * v[bj][n][0] + v[bj][n][1] * v[bj][n][1]) + (v[bj][n][2] * v[bj][n][2] + v[bj][n][3] * v[bj][n][3]); }
                ss += __shfl_xor(ss, 16); ss += __shfl_xor(ss, 32);
                const float rs = rsqrtf(ss * (1.f / 64.f) + RMS_EPS) * qscale;
#pragma unroll
                for (int bj = 0; bj < 2; ++bj)
#pragma unroll
                    for (int n = 0; n < 2; ++n) v[bj][n] = v[bj][n] * rs * wv[bj][n];
                if (rope) {
                    const int t = (r - NCTX) & 1023;
#pragma unroll
                    for (int bj = 0; bj < 2; ++bj) { const int pos = (bj == 0 ? (t >> 6) : (t & 63));
                        const pg8::f32x4 cs = *(const pg8::f32x4*)(rtab + pos * 32), sn = *(const pg8::f32x4*)(rtab + pos * 32 + 4);
                        const pg8::f32x4 x1 = v[bj][0], x2 = v[bj][1]; v[bj][0] = x1 * cs - x2 * sn; v[bj][1] = x2 * cs + x1 * sn; }
                }
                u16* rp = Q + (size_t)r * QKV_P + pn * 256 + wc * 64 + 4 * fq;
#pragma unroll
                for (int bj = 0; bj < 2; ++bj)
#pragma unroll
                    for (int n = 0; n < 2; ++n) { u32x2 o; o.x = pk2(v[bj][n][0], v[bj][n][1]); o.y = pk2(v[bj][n][2], v[bj][n][3]); *(u32x2*)(rp + 32 * bj + 16 * n) = o;
                        if (ok && !lat) *(pg8::f32x4*)(ok + ((size_t)r * nh + hd) * 64 + 32 * bj + 16 * n + 4 * fq) = v[bj][n]; }
                __builtin_amdgcn_sched_barrier(0);
            }
    }
};

struct EpiGate {
    static constexpr bool PERM = false, AFTER_DRAIN = false, HAS_MID = true; static constexpr int MID_T = 8;
    const Args* a;
    static DI pg8::f32x4 unpack4(u32x2 g) { pg8::f32x4 v; v[0] = __uint_as_float(g.x << 16); v[1] = __uint_as_float(g.x & 0xffff0000u); v[2] = __uint_as_float(g.y << 16); v[3] = __uint_as_float(g.y & 0xffff0000u); return v; }
    static DI pg8::f32x4 floor4(pg8::f32x4 v) { v[0] = fmaxf(v[0], 1e-30f); v[1] = fmaxf(v[1], 1e-30f); v[2] = fmaxf(v[2], 1e-30f); v[3] = fmaxf(v[3], 1e-30f); return v; }
    DI void mid(pg8::f32x4 (&acc)[2][2][4][2], const pg8::Unit& u, int wr, int wc, int fr, int fq) const {
        asm volatile("" : "+v"(fr), "+v"(fq));
        const u16* G = (const u16*)(a->ws + WS_G);
        const int row0 = u.pm * 256 + wr * 64 + fr, col0 = u.pn * 256 + wc * 32 + 4 * fq;
#pragma unroll
        for (int ai = 0; ai < 2; ++ai)
#pragma unroll
            for (int m = 0; m < 4; ++m) { const size_t r = row0 + ai * 128 + m * 16;
#pragma unroll
                for (int bj = 0; bj < 2; ++bj)
#pragma unroll
                    for (int n = 0; n < 2; ++n) { const int c = col0 + 128 * bj + 16 * n;
                        const pg8::f32x4 sa = unpack4(*(const u32x2*)(G + r * G_P + c)), sb = floor4(unpack4(*(const u32x2*)(G + r * G_P + 1024 + c)));
                        pg8::f32x4 q; q[0] = sa[0] * __builtin_amdgcn_rcpf(sb[0]); q[1] = sa[1] * __builtin_amdgcn_rcpf(sb[1]); q[2] = sa[2] * __builtin_amdgcn_rcpf(sb[2]); q[3] = sa[3] * __builtin_amdgcn_rcpf(sb[3]);
                        acc[ai][bj][m][n] *= q; } }
    }
    DI void mid128(pg8::f32x4 (&acc)[4][2], int pm, int pn, int wr, int wc, int fr, int fq) const {
        asm volatile("" : "+v"(fr), "+v"(fq));
        const u16* G = (const u16*)(a->ws + WS_G);
        const int row0 = pm * 128 + wr * 64 + fr, col0 = pn * 128 + wc * 32 + 4 * fq;
#pragma unroll
        for (int m = 0; m < 4; ++m) { const size_t r = row0 + m * 16;
#pragma unroll
            for (int n = 0; n < 2; ++n) { const int c = col0 + 16 * n;
                const pg8::f32x4 sa = unpack4(*(const u32x2*)(G + r * G_P + c)), sb = floor4(unpack4(*(const u32x2*)(G + r * G_P + 1024 + c)));
                pg8::f32x4 q; q[0] = sa[0] * __builtin_amdgcn_rcpf(sb[0]); q[1] = sa[1] * __builtin_amdgcn_rcpf(sb[1]); q[2] = sa[2] * __builtin_amdgcn_rcpf(sb[2]); q[3] = sa[3] * __builtin_amdgcn_rcpf(sb[3]);
                acc[m][n] *= q; } }
    }
    DI void epi128(const pg8::f32x4 (&acc)[4][2], int pm, int pn, int wr, int wc, int fr, int fq) const {
        asm volatile("" : "+v"(fr), "+v"(fq));
        const u16* G = (const u16*)(a->ws + WS_G) + 1024; u16* T = (u16*)(a->ws + WS_T);
        const int row0 = pm * 128 + wr * 64 + fr, col0 = pn * 128 + wc * 32 + 4 * fq;
#pragma unroll
        for (int m = 0; m < 4; ++m) { const size_t r = row0 + m * 16;
#pragma unroll
            for (int n = 0; n < 2; ++n) { const int c = col0 + 16 * n;
                const pg8::f32x4 v = acc[m][n] * floor4(unpack4(*(const u32x2*)(G + r * G_P + c)));
                u32x2 o; o.x = pk2(v[0], v[1]); o.y = pk2(v[2], v[3]); *(u32x2*)(T + r * DM + c) = o; } }
    }
    DI void operator()(AccRef acc, const pg8::Unit& u, int wr, int wc, int fr, int fq) const {
        asm volatile("" : "+v"(fr), "+v"(fq));
        const u16* G = (const u16*)(a->ws + WS_G) + 1024; u16* T = (u16*)(a->ws + WS_T);
        const int row0 = u.pm * 256 + wr * 64 + fr, col0 = u.pn * 256 + wc * 32 + 4 * fq;
#pragma unroll
        for (int ai = 0; ai < 2; ++ai)
#pragma unroll
            for (int m = 0; m < 4; ++m) { const size_t r = row0 + ai * 128 + m * 16;
#pragma unroll
                for (int bj = 0; bj < 2; ++bj)
#pragma unroll
                    for (int n = 0; n < 2; ++n) { const int c = col0 + 128 * bj + 16 * n;
                        const pg8::f32x4 v = acc[ai][bj][m][n] * floor4(unpack4(*(const u32x2*)(G + r * G_P + c)));
                        u32x2 o; o.x = pk2(v[0], v[1]); o.y = pk2(v[2], v[3]); *(u32x2*)(T + r * DM + c) = o; } }
    }
};

template <int FINAL> struct EpiRes {
    static constexpr bool PERM = false, AFTER_DRAIN = false, HAS_MID = false; static constexpr int MID_T = 0;
    const Args* a;
    DI void operator()(AccRef acc, const pg8::Unit& u, int wr, int wc, int fr, int fq) const {
        asm volatile("" : "+v"(fr), "+v"(fq));
        const int pm = u.pm; const int grp = pm < 32 ? 0 : 1 + ((pm - 32) >> 2);
        const float* gate = (const float*)(a->ws + WS_CTL) + grp * 6144 + (FINAL ? 5120 : 2048);
        float* out = FINAL ? a->out + OUT_Y : (float*)(a->ws + WS_TMP);
        const float* base = FINAL ? (const float*)(a->ws + WS_TMP) : (pm < 32 ? a->in[I_XP] : a->in[I_XS] - (size_t)NCTX * DM);
        const int row0 = pm * 256 + wr * 64 + fr, col0 = u.pn * 256 + wc * 32 + 4 * fq;
        pg8::f32x4 gv[2][2];
#pragma unroll
        for (int bj = 0; bj < 2; ++bj)
#pragma unroll
            for (int n = 0; n < 2; ++n) gv[bj][n] = *(const pg8::f32x4*)(gate + col0 + 128 * bj + 16 * n);
#pragma unroll
        for (int ai = 0; ai < 2; ++ai)
#pragma unroll
            for (int m = 0; m < 4; ++m) { const size_t r = row0 + ai * 128 + m * 16;
#pragma unroll
                for (int bj = 0; bj < 2; ++bj)
#pragma unroll
                    for (int n = 0; n < 2; ++n) { const int c = col0 + 128 * bj + 16 * n;
                        const pg8::f32x4 b = *(const pg8::f32x4*)(base + r * DM + c);
                        *(pg8::f32x4*)(out + r * DM + c) = b + gv[bj][n] * acc[ai][bj][m][n]; } }
    }
};

struct EpiResNorm {
    static constexpr bool PERM = false, AFTER_DRAIN = true, HAS_MID = false; static constexpr int MID_T = 0;
    const Args* a;
    DI void operator()(AccRef, const pg8::Unit&, int, int, int, int) const {}
    DI void fused(pg8::f32x4 (&acc)[2][2][4][2], const pg8::Unit& u, int wr, int wc, int fr, int fq, LAS unsigned char* lds, int wid, int lane) const {
        LAS float* P = (LAS float*)lds;
        LAS float* S = (LAS float*)(lds + 4096);
        const int pm = u.pm, grp = pm < 32 ? 0 : 1 + ((pm - 32) >> 2);
        const float* adag = (const float*)(a->ws + WS_CTL) + grp * 6144;
        float* TMP = (float*)(a->ws + WS_TMP);
        const float* base = pm < 32 ? a->in[I_XP] : a->in[I_XS] - (size_t)NCTX * DM;
        const int row0 = pm * 256 + wr * 64 + fr, col0 = u.pn * 256 + wc * 32 + 4 * fq;
        {
            pg8::f32x4 gv[2][2];
#pragma unroll
            for (int bj = 0; bj < 2; ++bj)
#pragma unroll
                for (int n = 0; n < 2; ++n) gv[bj][n] = *(const pg8::f32x4*)(adag + 2048 + col0 + 128 * bj + 16 * n);
#pragma unroll
            for (int ai = 0; ai < 2; ++ai)
#pragma unroll
                for (int m = 0; m < 4; ++m) { const size_t r = row0 + ai * 128 + m * 16; float ss = 0.f;
#pragma unroll
                    for (int bj = 0; bj < 2; ++bj)
#pragma unroll
                        for (int n = 0; n < 2; ++n) { const int c = col0 + 128 * bj + 16 * n;
                            const pg8::f32x4 x1 = *(const pg8::f32x4*)(base + r * DM + c) + gv[bj][n] * acc[ai][bj][m][n];
                            acc[ai][bj][m][n] = x1; *(pg8::f32x4*)(TMP + r * DM + c) = x1;
                            ss += (x1[0] * x1[0] + x1[1] * x1[1]) + (x1[2] * x1[2] + x1[3] * x1[3]); }
                    ss += __shfl_xor(ss, 16); ss += __shfl_xor(ss, 32);
                    if (fq == 0) P[(ai * 128 + wr * 64 + m * 16 + fr) * 4 + wc] = ss; }
        }
        asm volatile("s_waitcnt lgkmcnt(0)" ::: "memory"); __builtin_amdgcn_s_barrier(); asm volatile("" ::: "memory");
        float* slots = (float*)(a->ws + WS_RSS); unsigned* cnt = (unsigned*)(a->ws + WS_CTL + CTL_PANEL) + 64 * pm;
        const int row = wid * 32 + (lane & 31);
        if (lane < 32) { const float t = (P[row * 4 + 0] + P[row * 4 + 1]) + (P[row * 4 + 2] + P[row * 4 + 3]);
            __hip_atomic_store(slots + ((size_t)(pm * 256 + row) * 4 + u.pn), t, __ATOMIC_RELAXED, __HIP_MEMORY_SCOPE_AGENT); }
        asm volatile("s_waitcnt vmcnt(0)" ::: "memory");
        if (lane == 0) __hip_atomic_fetch_add(cnt, 1u, __ATOMIC_RELAXED, __HIP_MEMORY_SCOPE_AGENT);
        if (wid == 0) { unsigned sp = 0;
            while ((unsigned)__builtin_amdgcn_readfirstlane(__hip_atomic_load(cnt, __ATOMIC_RELAXED, __HIP_MEMORY_SCOPE_AGENT)) < 32u && ++sp < (1u << 20)) __builtin_amdgcn_s_sleep(2);
            __builtin_amdgcn_fence(__ATOMIC_ACQUIRE, "agent"); }
        asm volatile("s_waitcnt vmcnt(0) lgkmcnt(0)" ::: "memory"); __builtin_amdgcn_s_barrier(); asm volatile("" ::: "memory");
        if (lane < 32) { const float* sl = slots + (size_t)(pm * 256 + row) * 4; float t = 0.f;
#pragma unroll
            for (int q = 0; q < 4; ++q) t += __hip_atomic_load(sl + q, __ATOMIC_RELAXED, __HIP_MEMORY_SCOPE_AGENT);
            S[row] = rsqrtf(t * (1.f / DM) + RMS_EPS); }
        asm volatile("s_waitcnt lgkmcnt(0)" ::: "memory"); __builtin_amdgcn_s_barrier(); asm volatile("" ::: "memory");
        u16* H = (u16*)(a->ws + WS_H);
        pg8::f32x4 gm[2][2], sh[2][2];
#pragma unroll
        for (int bj = 0; bj < 2; ++bj)
#pragma unroll
            for (int n = 0; n < 2; ++n) { const int c = col0 + 128 * bj + 16 * n; gm[bj][n] = *(const pg8::f32x4*)(a->in[I_GFFN] + c) * (*(const pg8::f32x4*)(adag + 4096 + c) + 1.0f); sh[bj][n] = *(const pg8::f32x4*)(adag + 3072 + c); }
#pragma unroll
        for (int ai = 0; ai < 2; ++ai)
#pragma unroll
            for (int m = 0; m < 4; ++m) { const size_t r = row0 + ai * 128 + m * 16; const float rstd = S[ai * 128 + wr * 64 + m * 16 + fr];
#pragma unroll
                for (int bj = 0; bj < 2; ++bj)
#pragma unroll
                    for (int n = 0; n < 2; ++n) { const pg8::f32x4 y = (acc[ai][bj][m][n] * rstd) * gm[bj][n] + sh[bj][n];
                        u32x2 o; o.x = pk2(y[0], y[1]); o.y = pk2(y[2], y[3]); *(u32x2*)(H + r * DM + col0 + 128 * bj + 16 * n) = o; } }
    }
};

struct EpiSwiglu {
    static constexpr bool PERM = false, AFTER_DRAIN = false, HAS_MID = false; static constexpr int MID_T = 0;
    const Args* a;
    DI void operator()(AccRef acc, const pg8::Unit& u, int wr, int wc, int fr, int fq) const {
        asm volatile("" : "+v"(fr), "+v"(fq));
        u16* GU = (u16*)(a->ws + WS_GU);
        const int row0 = u.pm * 256 + wr * 64 + fr, col0 = u.pn * 128 + wc * 16 + 4 * fq;
#pragma unroll
        for (int ai = 0; ai < 2; ++ai)
#pragma unroll
            for (int m = 0; m < 4; ++m) { const size_t r = row0 + ai * 128 + m * 16;
#pragma unroll
                for (int bj = 0; bj < 2; ++bj) { const pg8::f32x4 g = acc[ai][bj][m][0], up = acc[ai][bj][m][1];
                    u32x2 o; o.x = pk2(siluf_(g[0]) * up[0], siluf_(g[1]) * up[1]); o.y = pk2(siluf_(g[2]) * up[2], siluf_(g[3]) * up[3]);
                    *(u32x2*)(GU + r * DFF + col0 + 64 * bj) = o; } }
    }
};
template <class Epi>
DI void gemm128_phase(LAS unsigned char* lds, const pg8::Gemm g, const Epi& E) {
    int tid_ = threadIdx.x; asm volatile("" : "+v"(tid_));
    const int tid = tid_, wid = __builtin_amdgcn_readfirstlane(tid >> 6), lane = tid & 63, wr = wid >> 2, wc = wid & 3, fr = lane & 15, fq = lane >> 4;
    const int K = g.K, nt = K / 64, nN = g.N / 128, nun = (g.M / 128) * nN;
    unsigned voff[2];
#pragma unroll
    for (int i = 0; i < 2; ++i) { int R, C; pg8::stage_rc(tid * 16 + i * 8192, R, C); voff[i] = (unsigned)(R * K + C) * 2u; }
    const unsigned ldsw = (unsigned)wid * 1024u;
    const int aoff = pg8::lds_byte(wr * 64 + fr, fq * 8), boff = pg8::lds_byte(wc * 32 + fr, fq * 8);
#define G128_STAGE(buf, kt) do { const char* ga_ = cA + (size_t)(kt) * 128; const char* gb_ = cB + (size_t)(kt) * 128; _Pragma("unroll") for (int _i = 0; _i < 2; ++_i) { \
        __builtin_amdgcn_global_load_lds((const unsigned*)(ga_ + voff[_i]), (LAS unsigned*)(lds + (buf) * 32768 + ldsw + _i * 8192), 16, 0, 0); \
        __builtin_amdgcn_global_load_lds((const unsigned*)(gb_ + voff[_i]), (LAS unsigned*)(lds + (buf) * 32768 + 16384 + ldsw + _i * 8192), 16, 0, 0); } } while (0)
    for (int u = blockIdx.x; u < nun; u += gridDim.x) {
        const int pm = u / nN, pn = u % nN;
        const char* cA = (const char*)g.A + (size_t)pm * 128 * K * 2; const char* cB = (const char*)g.Bt + (size_t)pn * 128 * K * 2;
        pg8::f32x4 acc[4][2];
#pragma unroll
        for (int m = 0; m < 4; ++m)
#pragma unroll
            for (int n = 0; n < 2; ++n) acc[m][n] = (pg8::f32x4){0.f, 0.f, 0.f, 0.f};
        G128_STAGE(0, 0); G128_STAGE(1, 1);
        int buf = 0;
        for (int t = 0; t < nt; ++t) {
            if (t + 1 < nt) asm volatile("s_waitcnt vmcnt(4)" ::: "memory"); else asm volatile("s_waitcnt vmcnt(0)" ::: "memory");
            __builtin_amdgcn_s_barrier(); __builtin_amdgcn_sched_barrier(0);
            if (t + 2 < nt) { const int nb = buf == 0 ? 2 : buf - 1; G128_STAGE(nb, t + 2); }
            if constexpr (Epi::HAS_MID) { if (t == Epi::MID_T) E.mid128(acc, pm, pn, wr, wc, fr, fq); }
            pg8::bf16x8 At[4][2], Bf[2][2];
#pragma unroll
            for (int n = 0; n < 2; ++n)
#pragma unroll
                for (int k = 0; k < 2; ++k) Bf[n][k] = *(const LAS pg8::bf16x8*)(lds + buf * 32768 + 16384 + boff + n * 2048 + k * 1024);
#pragma unroll
            for (int m = 0; m < 4; ++m)
#pragma unroll
                for (int k = 0; k < 2; ++k) At[m][k] = *(const LAS pg8::bf16x8*)(lds + buf * 32768 + aoff + m * 2048 + k * 1024);
            asm volatile("s_waitcnt lgkmcnt(0)" ::: "memory"); __builtin_amdgcn_sched_barrier(0);
            __builtin_amdgcn_s_setprio(1);
#pragma unroll
            for (int m = 0; m < 4; ++m)
#pragma unroll
                for (int n = 0; n < 2; ++n)
#pragma unroll
                    for (int k = 0; k < 2; ++k) acc[m][n] = __builtin_amdgcn_mfma_f32_16x16x32_bf16(Bf[n][k], At[m][k], acc[m][n], 0, 0, 0);
            __builtin_amdgcn_s_setprio(0);
            buf = buf == 2 ? 0 : buf + 1;
        }
        E.epi128(acc, pm, pn, wr, wc, fr, fq);
        __builtin_amdgcn_s_barrier(); __builtin_amdgcn_sched_barrier(0);
    }
#undef G128_STAGE
}
#define MFMA32(a, b, c) __builtin_amdgcn_mfma_f32_32x32x16_bf16((a), (b), (c), 0, 0, 0)
struct AState { float m, l; f32x16 o0, o1; };
struct AMask { int dq; int e0; const LAS float* bp; bool rowok; };
struct KVFrag { bf16x8 k[4]; bf16x8 v[4]; };
DI int koff_(int i, int h) { return (i & 7) + 16 * (i >> 3) + 8 * h; }

DI void attn_load(KVFrag& f, const u16* kp, const u16* vp, size_t v32) {
#pragma unroll
    for (int t = 0; t < 4; ++t) f.k[t] = *(const bf16x8*)(kp + 16 * t);
#pragma unroll
    for (int dt = 0; dt < 2; ++dt)
#pragma unroll
        for (int sI = 0; sI < 2; ++sI) f.v[dt * 2 + sI] = *(const bf16x8*)(vp + dt * v32 + 16 * sI);
}

template <int MODE>
DI void attn_compute(AState& st, const bf16x8 (&qf)[4], const KVFrag& f, int h, const AMask& mk) {
    f32x16 s;
#pragma unroll
    for (int i = 0; i < 16; ++i) s[i] = 0.f;
#pragma unroll
    for (int t = 0; t < 4; ++t) s = MFMA32(f.k[t], qf[t], s);
    float tmax = -1e30f;
#pragma unroll
    for (int i = 0; i < 16; ++i) {
        float v = s[i]; const int c = koff_(i, h);
        if (MODE == 1) { const int d = mk.dq - c; v = (d <= 128 && d >= -128) ? v : -INFINITY; }
        if (MODE == 2) { const bool ok = mk.rowok && (unsigned)(mk.e0 + c) < 16u; const float b = mk.bp[ok ? c : -mk.e0]; v = ok ? v + b : -INFINITY; }
        s[i] = v; tmax = fmaxf(tmax, v);
    }
    tmax = fmaxf(tmax, __shfl_xor(tmax, 32));
    const float mnew = fmaxf(st.m, tmax), alpha = __builtin_amdgcn_exp2f(st.m - mnew);
    st.m = mnew;
    float psum = 0.f;
#pragma unroll
    for (int i = 0; i < 16; ++i) { const float p = __builtin_amdgcn_exp2f(s[i] - mnew); s[i] = p; psum += p; }
    st.l = st.l * alpha + psum;
#pragma unroll
    for (int i = 0; i < 16; ++i) { st.o0[i] *= alpha; st.o1[i] *= alpha; }
#pragma unroll
    for (int sI = 0; sI < 2; ++sI) {
        u32x4 pw; pw.x = pk2(s[8 * sI], s[8 * sI + 1]); pw.y = pk2(s[8 * sI + 2], s[8 * sI + 3]); pw.z = pk2(s[8 * sI + 4], s[8 * sI + 5]); pw.w = pk2(s[8 * sI + 6], s[8 * sI + 7]);
        const bf16x8 pb = __builtin_bit_cast(bf16x8, pw);
        st.o0 = MFMA32(f.v[sI], pb, st.o0);
        st.o1 = MFMA32(f.v[2 + sI], pb, st.o1);
    }
}

struct ASeg { const u16* kp; size_t kstep; const u16* vp; size_t v32; int n; int vstep; };
template <int KIND>
DI void attn_run(AState& st, const bf16x8 (&qf)[4], const ASeg& L, const ASeg& C, int h, int r, int w0, int w1, int w2, const LAS float* rpb_l) {
    const int nL = L.n, n = nL;
    KVFrag fa, fb;
#define A_LOAD(F, t) do { const int t_ = (t); attn_load(F, L.kp + t_ * L.kstep, L.vp + L.vstep * t_, L.v32); } while (0)
#define A_COMP(F, t) do { const int t_ = (t); AMask mk; mk.dq = 0; mk.e0 = 0; mk.bp = rpb_l; mk.rowok = true; \
        if (KIND && t_ < nL) { \
            if (KIND == 1) { mk.dq = (w0 - t_) * 32 + r;   if (w0 - t_ != 4 && w0 - t_ != -4) { attn_compute<0>(st, qf, F, h, mk); break; }   } \
            if (KIND == 2) { mk.e0 = w1;   mk.rowok = (unsigned)(t_ - w2) < 8u;   mk.bp = rpb_l + w0 + t_ * 31;   } \
            attn_compute<KIND>(st, qf, F, h, mk); \
        } else attn_compute<0>(st, qf, F, h, mk); } while (0)
    A_LOAD(fa, 0);
    for (int t = 0; t < n; t += 2) {
        if (t + 1 < n) A_LOAD(fb, t + 1);
        A_COMP(fa, t);
        if (t + 1 < n) { if (t + 2 < n) A_LOAD(fa, t + 2); A_COMP(fb, t + 1); }
    }
#undef A_LOAD
#undef A_COMP
}

DI void attn_lds_ctx(AState& st, const bf16x8 (&qf)[4], const LAS unsigned char* kl, const LAS unsigned char* vl, int pr, int r, int h, const LAS float* rpb_l) {
    const LAS unsigned char* kp_l = kl + pr * 144 + 16 * h; const LAS unsigned char* vp_l = vl + r * 528 + 16 * h;
    AMask mk; mk.dq = 0; mk.e0 = 0; mk.bp = rpb_l; mk.rowok = true;
#pragma unroll 1
    for (int kt = 0; kt < 8; ++kt) {
        KVFrag f;
#pragma unroll
        for (int t = 0; t < 4; ++t) f.k[t] = *(const LAS bf16x8*)(kp_l + kt * 32 * 144 + 32 * t);
#pragma unroll
        for (int dt = 0; dt < 2; ++dt)
#pragma unroll
            for (int sI = 0; sI < 2; ++sI) f.v[dt * 2 + sI] = *(const LAS bf16x8*)(vp_l + dt * 32 * 528 + kt * 64 + 32 * sI);
        attn_compute<0>(st, qf, f, h, mk);
    }
}

#ifndef LAT_GRP
#define LAT_GRP 8
#endif
#ifndef ATT_REV
#define ATT_REV 0
#endif
constexpr int N_ITEMS_LB = 512, N_ITEMS_LA = 512, N_ITEMS_CTX = 4096, N_ITEMS = N_ITEMS_LB + N_ITEMS_LA + N_ITEMS_CTX;

DI void attn_phase(const Args& a, int qi, LAS unsigned char* lds) {
    int tid_ = threadIdx.x; asm volatile("" : "+v"(tid_));
    unsigned char* ws = a.ws;
    unsigned* queue = (unsigned*)(ws + WS_CTL + CTL_QUEUE) + 64 * qi;
    const u16* QKV = (const u16*)(ws + WS_QKV);
    LAS float* rpb_l = (LAS float*)lds;
    for (int i = tid_; i < 8 * 15 * 31; i += 512) rpb_l[i] = a.in[I_RPB][i] * 1.4426950408889634f;
    __syncthreads();
    volatile LAS unsigned* qslot = (volatile LAS unsigned*)(lds + 16384);
    const int wave = __builtin_amdgcn_readfirstlane(tid_ >> 6);
    unsigned nextq = 0;
    if (tid_ == 0) nextq = atomicAdd(queue, 1u);
    for (;;) {
        __syncthreads();
        if (tid_ == 0) *qslot = nextq;
        __syncthreads();
        const int grp = __builtin_amdgcn_readfirstlane(*qslot);
        constexpr int N_LAT_GROUPS = (N_ITEMS_LB + N_ITEMS_LA) / LAT_GRP, N_GROUPS = N_LAT_GROUPS + N_ITEMS_CTX / 8;
        if (grp >= N_GROUPS) break;
        if (tid_ == 0) nextq = atomicAdd(queue, 1u);
        const bool latg = grp < N_LAT_GROUPS;
        const int base = latg ? grp * LAT_GRP : N_ITEMS_LB + N_ITEMS_LA + (grp - N_LAT_GROUPS) * 8;
        LAS unsigned char* kl = lds + 32768; LAS unsigned char* vl = lds + 32768 + 256 * 144;
        { const u16* ksrc; const u16* vsrc; int kpitch;
          if (latg) { if (base < N_ITEMS_LB) { const int b = base >> 8, hd = (base >> 5) & 7; ksrc = (const u16*)(ws + WS_CKB) + (size_t)b * 256 * 512 + 64 * hd; kpitch = 512; vsrc = (const u16*)(ws + WS_VCB) + (size_t)(b * 8 + hd) * 64 * 256; }
                      else { const int i2 = base - N_ITEMS_LB, b = i2 >> 8, kvh = ((i2 >> 5) & 7) >> 2; ksrc = (const u16*)(ws + WS_CKA) + (size_t)b * 256 * 128 + 64 * kvh; kpitch = 128; vsrc = (const u16*)(ws + WS_VCA) + (size_t)(b * 2 + kvh) * 64 * 256; } }
          else { const int i3 = base - N_ITEMS_LB - N_ITEMS_LA, b = i3 >> 7, hh = (i3 >> 3) & 15; const int hd = hh < 8 ? hh : hh - 8, kvh = hd >> 2; kpitch = QKV_P;
                 ksrc = QKV + (size_t)b * 256 * QKV_P + (hh < 8 ? 512 + 64 * kvh : 1280 + 64 * hd);
                 vsrc = hh < 8 ? (const u16*)(ws + WS_VTA_CTX) + (size_t)(b * 2 + kvh) * 64 * 256 : (const u16*)(ws + WS_VTB_CTX) + (size_t)(b * 8 + hd) * 64 * 256; }
#pragma unroll
          for (int i = 0; i < 4; ++i) { const int idx = tid_ + 512 * i;
              const u32x4 kv = *(const u32x4*)(ksrc + (size_t)(idx >> 3) * kpitch + 8 * (idx & 7));
              const u32x4 vv = *(const u32x4*)(vsrc + (size_t)(idx >> 5) * 256 + 8 * (idx & 31));
              *(LAS u32x4*)(kl + (idx >> 3) * 144 + 16 * (idx & 7)) = kv;
              *(LAS u32x4*)(vl + (idx >> 5) * 528 + 16 * (idx & 31)) = vv; }
        }
        __syncthreads();
        if (latg && wave >= LAT_GRP) continue;
        const int it = base + wave;
        int lane_ = tid_ & 63; asm volatile("" : "+v"(lane_));
        const int r = lane_ & 31, h = lane_ >> 5, pr = (r & 19) | ((r & 4) << 1) | ((r & 8) >> 1);
        AState st;
#pragma unroll
        for (int i = 0; i < 16; ++i) { st.o0[i] = 0.f; st.o1[i] = 0.f; }
        st.m = -1e30f; st.l = 0.f;
        bf16x8 qf[4];
        u16* outp;
        if (it < N_ITEMS_LB) {
            const int b = it >> 8, hd = (it >> 5) & 7, qt = it & 31, rq0 = (qt >> 2) * 2, c0 = (qt & 3) * 16;
            const int rq = rq0 + (r >> 4), cq = c0 + (r & 15);
            const size_t tok0 = (size_t)NCTX + b * 1024;
            const u16* qp = QKV + (tok0 + rq * 64 + cq) * QKV_P + 768 + 64 * hd + 8 * h;
#pragma unroll
            for (int t = 0; t < 4; ++t) qf[t] = *(const bf16x8*)(qp + 16 * t);
            const int cs = min(max(cq - 8, 0), 48), rs = min(max(rq - 4, 0), 8);
            const int kr0 = min(max(rq0 - 4, 0), 8), kr1 = min(max(rq0 + 1 - 4, 0), 8) + 7;
            const int wst = min(max(c0 - 8, 0), 32);
            ASeg L, C;
            L.kp = QKV + (tok0 + kr0 * 64 + wst + pr) * QKV_P + 1280 + 64 * hd + 8 * h; L.kstep = (size_t)64 * QKV_P;
            L.vp = (const u16*)(ws + WS_VTB_LAT) + ((size_t)(b * 8 + hd) * 64 + r) * 1024 + kr0 * 64 + wst + 8 * h; L.v32 = (size_t)32 * 1024; L.n = kr1 - kr0 + 1; L.vstep = 64;
            C.kp = (const u16*)(ws + WS_CKB) + ((size_t)b * 256 + pr) * 512 + 64 * hd + 8 * h; C.kstep = (size_t)32 * 512;
            C.vp = (const u16*)(ws + WS_VCB) + ((size_t)(b * 8 + hd) * 64 + r) * 256 + 8 * h; C.v32 = (size_t)32 * 256; C.n = 0; C.vstep = 32;
            attn_run<2>(st, qf, L, C, h, r, (hd * 15 + kr0 - rq + 7) * 31 + (wst - cq + 15), wst - cs, rs - kr0, rpb_l);
            attn_lds_ctx(st, qf, kl, vl, pr, r, h, rpb_l);
            outp = (u16*)(ws + WS_YA) + (tok0 + rq * 64 + cq) * 1024 + 512 + 64 * hd;
        } else if (it < N_ITEMS_LB + N_ITEMS_LA) {
            const int i2 = it - N_ITEMS_LB, b = i2 >> 8, hd = (i2 >> 5) & 7, qt = i2 & 31, kvh = hd >> 2;
            const size_t tok0 = (size_t)NCTX + b * 1024;
            const u16* qp = QKV + (tok0 + qt * 32 + r) * QKV_P + 64 * hd + 8 * h;
#pragma unroll
            for (int t = 0; t < 4; ++t) qf[t] = *(const bf16x8*)(qp + 16 * t);
            st.m = a.in[I_SINK][hd] * 1.4426950408889634f; st.l = h == 0 ? 1.f : 0.f;
            const int k_lo = max(qt - 4, 0), k_hi = min(qt + 4, 31);
            ASeg L, C;
            L.kp = QKV + (tok0 + k_lo * 32 + pr) * QKV_P + 512 + 64 * kvh + 8 * h; L.kstep = (size_t)32 * QKV_P;
            L.vp = (const u16*)(ws + WS_VTA_LAT) + ((size_t)(b * 2 + kvh) * 64 + r) * 1024 + k_lo * 32 + 8 * h; L.v32 = (size_t)32 * 1024; L.n = k_hi - k_lo + 1; L.vstep = 32;
            C.kp = (const u16*)(ws + WS_CKA) + ((size_t)b * 256 + pr) * 128 + 64 * kvh + 8 * h; C.kstep = (size_t)32 * 128;
            C.vp = (const u16*)(ws + WS_VCA) + ((size_t)(b * 2 + kvh) * 64 + r) * 256 + 8 * h; C.v32 = (size_t)32 * 256; C.n = 0; C.vstep = 32;
            attn_run<1>(st, qf, L, C, h, r, qt - k_lo, 0, 0, rpb_l);
            attn_lds_ctx(st, qf, kl, vl, pr, r, h, rpb_l);
            outp = (u16*)(ws + WS_YA) + (tok0 + qt * 32 + r) * 1024 + 64 * hd;
        } else {
            const int i3 = base - N_ITEMS_LB - N_ITEMS_LA, b = i3 >> 7, hh = (i3 >> 3) & 15, qt = wave;
            const size_t tok0 = (size_t)b * 256;
            const int hd = hh < 8 ? hh : hh - 8, kvh = hd >> 2;
            const u16* qp = QKV + (tok0 + qt * 32 + r) * QKV_P + (hh < 8 ? 64 * hd : 768 + 64 * hd) + 8 * h;
#pragma unroll
            for (int t = 0; t < 4; ++t) qf[t] = *(const bf16x8*)(qp + 16 * t);
            if (hh < 8) { st.m = a.in[I_SINK][hd] * 1.4426950408889634f; st.l = h == 0 ? 1.f : 0.f; }
            outp = (u16*)(ws + WS_YA) + (tok0 + qt * 32 + r) * 1024 + (hh < 8 ? 0 : 512) + 64 * hd;
            attn_lds_ctx(st, qf, kl, vl, pr, r, h, rpb_l);
        }
        const float l = st.l + __shfl_xor(st.l, 32), inv = 1.f / l;
#pragma unroll
        for (int g = 0; g < 4; ++g) {
            u32x2 o; o.x = pk2(st.o0[4 * g] * inv, st.o0[4 * g + 1] * inv); o.y = pk2(st.o0[4 * g + 2] * inv, st.o0[4 * g + 3] * inv);
            *(u32x2*)(outp + 8 * g + 4 * h) = o;
            o.x = pk2(st.o1[4 * g] * inv, st.o1[4 * g + 1] * inv); o.y = pk2(st.o1[4 * g + 2] * inv, st.o1[4 * g + 3] * inv);
            *(u32x2*)(outp + 32 + 8 * g + 4 * h) = o;
        }
    }
}
constexpr int N_PHASES = 9;
#ifndef LATE_D_IN_P7
#define LATE_D_IN_P7 0
#endif
#ifndef LATE_GU_IN_P2
#define LATE_GU_IN_P2 0
#endif
#ifndef USE_G128
#define USE_G128 0
#endif
#ifndef TS_PROBE
#define TS_PROBE 0
#endif
#ifndef DUP_MASK
#define DUP_MASK 0
#endif
__global__ void __launch_bounds__(512, 2) fwd_mega(Args args) {
    extern __shared__ __attribute__((aligned(16))) unsigned char lds_raw[];
    LAS unsigned char* lds = (LAS unsigned char*)lds_raw;
    cg::grid_group grid = cg::this_grid();
    const int lo = args.ph_lo, hi = args.ph_hi;
    const bool fuse56 = gridDim.x >= 160;
    unsigned char* ws = args.ws;
#ifndef PHASE_MASK
#define PHASE_MASK 0x1ff
#endif
#define IN(k) (((PHASE_MASK >> (k)) & 1) && lo <= (k) && (k) < hi)
#define SEAM(k) do { if (IN(k) && IN((k) + 1)) xcd_barrier(xb); STAMP((k) + 1); } while (0)
#if TS_PROBE
#define STAMP(i) do { if (blockIdx.x == 0 && threadIdx.x == 0) ((unsigned long long*)(ws + WS_CTL + 116736))[i] = __builtin_amdgcn_s_memrealtime(); } while (0)
#else
#define STAMP(i) do { } while (0)
#endif
    if (lo < 0) grid.sync();
    volatile LAS unsigned* xst = (volatile LAS unsigned*)(lds + LDS_XB);
    if (threadIdx.x < 4) xst[threadIdx.x] = 0u;
    __syncthreads();
    XcdBarrier xb; xb.bar = (unsigned*)(ws + WS_CTL + CTL_BAR); xb.x = 0; xb.st = xst;
    if (hi - lo > 1) xb = xcd_barrier_post((unsigned*)(ws + WS_CTL + CTL_BAR), xst);
    STAMP(0);
    if (IN(0)) { p0_prologue(args, lds, true); if (DUP_MASK & 1) p0_prologue(args, lds, false); }
    STAMP(1);
    if (IN(1)) { norm_mod_phase(args, 0); if (DUP_MASK & 2) norm_mod_phase(args, 0); }
    SEAM(1);
    if (DUP_MASK & 512) { for (int q = 0; q < 8; ++q) xcd_barrier(xb); }
    if (IN(2)) {
        pg8::Gemm g{(const pg8::bf16_t*)(ws + WS_H), (const pg8::bf16_t*)(ws + WS_WIN), MTOK, DIN, DM}; pg8::StaticOrder S; S.init(MTOK, DIN, gridDim.x, blockIdx.x, (DUP_MASK & 4) ? 2 : 1);
        EpiIn E{&args, lds};
        pg8::gemm_phase<EpiIn, pg8::StaticOrder, true, true>(lds, g, S, E);
        if ((int)gridDim.x >= LATE_MIN_GRID) { const int busy = (40 * 17) % (int)gridDim.x;
            if (busy > 0 && (int)blockIdx.x >= busy) { p0_late_transposes(args, lds, 0, blockIdx.x - busy, gridDim.x - busy); if (LATE_GU_IN_P2) p0_late_transposes(args, lds, 1, blockIdx.x - busy, gridDim.x - busy); }
            else if (busy == 0) { p0_late_transposes(args, lds, 0, blockIdx.x, gridDim.x); if (LATE_GU_IN_P2) p0_late_transposes(args, lds, 1, blockIdx.x, gridDim.x); } }
    }
    SEAM(2);
    if (IN(3)) { attn_phase(args, 0, lds); if (DUP_MASK & 8) attn_phase(args, 1, lds); }
    SEAM(3);
    if (IN(4)) {
        if (!LATE_GU_IN_P2 && !USE_G128 && (int)gridDim.x >= LATE_MIN_GRID && blockIdx.x >= 160) p0_late_transposes(args, lds, 1, blockIdx.x - 160, gridDim.x - 160);
        pg8::StaticOrder S; S.init(MTOK, DM, gridDim.x, blockIdx.x, (DUP_MASK & 16) ? 2 : 1);
        { pg8::Gemm g{(const pg8::bf16_t*)(ws + WS_YA), (const pg8::bf16_t*)(ws + WS_WOA), MTOK, DM, 1024}; EpiGate E{&args};
          if (USE_G128) gemm128_phase<EpiGate>(lds, g, E); else pg8::gemm_phase<EpiGate, pg8::StaticOrder, true, true>(lds, g, S, E); }
        STAMP(10);
    }
    SEAM(4);
    if (IN(5)) {
        if ((int)gridDim.x >= LATE_MIN_GRID && blockIdx.x >= 160) { if (USE_G128) p0_late_transposes(args, lds, 1, blockIdx.x - 160, gridDim.x - 160); if (!LATE_D_IN_P7) p0_late_transposes(args, lds, 2, blockIdx.x - 160, gridDim.x - 160); }
        pg8::Gemm g{(const pg8::bf16_t*)(ws + WS_T), (const pg8::bf16_t*)(ws + WS_WO), MTOK, DM, DM}; pg8::StaticOrder S; S.init(MTOK, DM, gridDim.x, blockIdx.x, (DUP_MASK & 32) ? 2 : 1);
        if (fuse56) { EpiResNorm E{&args}; pg8::gemm_phase<EpiResNorm, pg8::StaticOrder, false, true>(lds, g, S, E); }
        else { EpiRes<0> E{&args}; pg8::gemm_phase<EpiRes<0>, pg8::StaticOrder, true, true>(lds, g, S, E); }
    }
    SEAM(5);
    if (!fuse56) {
    if (IN(6)) { norm_mod_phase(args, 1); }
    SEAM(6);
    }
    if (IN(7)) {
        pg8::Gemm g{(const pg8::bf16_t*)(ws + WS_H), (const pg8::bf16_t*)(ws + WS_WGU), MTOK, NGU, DM}; pg8::StaticOrder S; S.init(MTOK, NGU, gridDim.x, blockIdx.x, (DUP_MASK & 128) ? 2 : 1);
        EpiSwiglu E{&args};
        pg8::gemm_phase<EpiSwiglu, pg8::StaticOrder, true, true>(lds, g, S, E);
        if (LATE_D_IN_P7 && (int)gridDim.x >= LATE_MIN_GRID) { const int busy = (40 * 22) % (int)gridDim.x;
            if (busy > 0 && (int)blockIdx.x >= busy) p0_late_transposes(args, lds, 2, blockIdx.x - busy, gridDim.x - busy); else if (busy == 0) p0_late_transposes(args, lds, 2, blockIdx.x, gridDim.x); }
    }
    SEAM(7);
    if (IN(8)) {
        pg8::Gemm g{(const pg8::bf16_t*)(ws + WS_GU), (const pg8::bf16_t*)(ws + WS_WD), MTOK, DM, DFF}; pg8::StaticOrder S; S.init(MTOK, DM, gridDim.x, blockIdx.x, (DUP_MASK & 256) ? 2 : 1);
        EpiRes<1> E{&args};
        pg8::gemm_phase<EpiRes<1>, pg8::StaticOrder, true, false>(lds, g, S, E);
    }
#if TS_PROBE
    STAMP(9);
    if (blockIdx.x == 0 && threadIdx.x == 0) {
        const unsigned long long* ts = (const unsigned long long*)(ws + WS_CTL + 116736);
        const int sI[11] = {0, 1, 2, 3, 4, 5, 6, 6, 8, 4, 0}, eI[11] = {1, 2, 3, 4, 5, 6, 6, 8, 9, 10, 9};
        const unsigned long long d = ts[eI[TS_PROBE - 1]] - ts[sI[TS_PROBE - 1]];
        const unsigned long long t_end = __builtin_amdgcn_s_memrealtime() + 10ull * d;
        while (__builtin_amdgcn_s_memrealtime() < t_end) __builtin_amdgcn_s_sleep(8);
    }
#endif
#undef IN
#undef SEAM
}

#ifndef N_LAUNCH_MODE
#define N_LAUNCH_MODE 1
#endif
extern "C" void kernel_launch(void* const* d_in, const int* in_sizes, int n_in, void* d_out, int out_size, void* d_ws, size_t ws_size, hipStream_t stream) {
    static int grid = 0;
    if (grid == 0) {
        int dev = 0, cus = 0, per_cu = 0;
        (void)hipGetDevice(&dev);
        (void)hipDeviceGetAttribute(&cus, hipDeviceAttributeMultiprocessorCount, dev);
        (void)hipFuncSetAttribute((const void*)fwd_mega, hipFuncAttributeMaxDynamicSharedMemorySize, LDS_BYTES);
        (void)hipOccupancyMaxActiveBlocksPerMultiprocessor(&per_cu, (const void*)fwd_mega, 512, LDS_BYTES);
        if (per_cu < 1) { fprintf(stderr, "occupancy query says %d blocks/CU\n", per_cu); per_cu = 1; }
        if (per_cu > 1) per_cu = 1;
        grid = cus * per_cu;
        if (n_in != 25) fprintf(stderr, "kernel_launch: expected 25 inputs, got %d\n", n_in);
    }
    (void)hipMemsetAsync((char*)d_ws + WS_CTL, 0, CTL_BYTES, stream);
    Args a{};
    for (int i = 0; i < 25; ++i) a.in[i] = (const float*)d_in[i];
    a.out = (float*)d_out; a.ws = (unsigned char*)d_ws;
    if (N_LAUNCH_MODE == 1 || N_LAUNCH_MODE == 2) {
        a.ph_lo = 0; a.ph_hi = N_PHASES;
        void* kargs[] = {&a};
        hipError_t e = hipLaunchCooperativeKernel((const void*)fwd_mega, dim3(grid), dim3(512), kargs, LDS_BYTES, stream);
        if (e != hipSuccess) fprintf(stderr, "cooperative launch failed: %s (grid %d)\n", hipGetErrorString(e), grid);
        if (N_LAUNCH_MODE == 2) {
            (void)hipMemsetAsync((char*)d_ws + WS_CTL + 81920, 0, CTL_BYTES - 81920, stream);
            (void)hipLaunchCooperativeKernel((const void*)fwd_mega, dim3(grid), dim3(512), kargs, LDS_BYTES, stream); }
    } else {
        for (int p = 0; p < N_PHASES; ++p) { a.ph_lo = p; a.ph_hi = p + 1; hipLaunchKernelGGL(fwd_mega, dim3(grid), dim3(512), LDS_BYTES, stream, a); }
    }
}
```
